# Optimizing an MI355X kernel written in HIP

```python
import jax
import jax.numpy as jnp
from jax import lax
import numpy as np

D_MODEL = 2048
BATCH = 4
SEQ = 4096
DEPTH = 4

GRID_W = 64
CTX_LEN = 256
N_EVEN = (DEPTH + 1) // 2
N_ODD = DEPTH // 2
EPS_RMS = 1e-6
D_A = D_MODEL // 2
HEAD_A = 64
H_A = D_A // HEAD_A
R_W = 64
R_A = 64
GN_EPS = 64e-5
D_B = D_MODEL // 2
HEAD_B = 64
H_B = D_B // HEAD_B
NA_WIN_H = 8
NA_WIN_W = 16
RG_BLOCKS = 16
D_C = (4 * D_MODEL // 3) // (RG_BLOCKS * 16) * (RG_BLOCKS * 16)
RG_BS = D_C // RG_BLOCKS
CONV_W = 4
CONV_LEFT = 2
RGLRU_C = 8.0
SCAN_DIRECTIONS = (False, True)

A_SHIFTED = 3 * D_A + 2 * R_W + 2 * R_A
EV_IN = A_SHIFTED + D_A + 4 * D_B
EV_SPLITS = (A_SHIFTED, A_SHIFTED + D_A, A_SHIFTED + D_A + D_B, A_SHIFTED + D_A + 2 * D_B, A_SHIFTED + D_A + 3 * D_B)
RW_SPLITS = (D_A, 2 * D_A, 3 * D_A, 3 * D_A + 2 * R_W)

kernel_name = "hybrid_rwkv7_natten_rglru_prefix_dit"


def rmsnorm(x, g):
    xf = x.astype(jnp.float32)
    y = xf * lax.rsqrt(jnp.mean(xf * xf, axis=-1, keepdims=True) + EPS_RMS)
    return (y * g).astype(x.dtype)


def heads(t, dh):
    return t.reshape(t.shape[0], t.shape[1], -1, dh)


def token_shift(f, mu):
    prev = jnp.pad(f[:, :-1], ((0, 0), (1, 0), (0, 0)))
    nxt = jnp.pad(f[:, 1:], ((0, 0), (0, 1), (0, 0)))
    return f + mu[0] * (prev - f) + mu[1] * (nxt - f)


def rwkv7_prepare(f, mu, w0, w_up, a0, a_up, k_k, k_a):
    f = token_shift(f.astype(jnp.float32), mu)
    r, k, v, cw, ca = jnp.split(f, RW_SPLITS, axis=-1)
    B, T = f.shape[:2]
    cw = cw.reshape(B, T, 2, R_W)
    ca = ca.reshape(B, T, 2, R_A)
    w_log = -jax.nn.softplus(-(w0 + jnp.einsum('btdr,drc->btdc', jnp.tanh(cw), w_up))) - 0.5
    decay = jnp.exp(-jnp.exp(w_log))
    a = jax.nn.sigmoid(a0 + jnp.einsum('btdr,drc->btdc', ca, a_up))
    kk = heads(k * k_k, HEAD_A)
    kk = kk * lax.rsqrt(jnp.sum(kk * kk, axis=-1, keepdims=True) + 1e-12)
    k_dir = k[:, :, None] * (1.0 + (a - 1.0) * k_a)
    split_heads = lambda t: t.reshape(B, T, 2, H_A, HEAD_A)
    return (heads(r, HEAD_A), heads(v, HEAD_A), kk, split_heads(decay), split_heads(k_dir), split_heads(a))


def rwkv7_scan(S0, r, decay, k, v, kk, a, reverse):
    def step(S, inp):
        r_t, w_t, k_t, v_t, kk_t, a_t = inp
        S = (S * w_t[:, :, None, :]
             - jnp.einsum('bhvk,bhk->bhv', S, kk_t)[..., None] * (kk_t * a_t)[:, :, None, :]
             + v_t[..., None] * k_t[:, :, None, :])
        return S, jnp.einsum('bhvk,bhk->bhv', S, r_t)
    xs = tuple(jnp.moveaxis(t, 1, 0) for t in (r, decay, k, v, kk, a))
    S, o = lax.scan(step, S0, xs, reverse=reverse)
    return S, jnp.moveaxis(o, 0, 1)


def rwkv7_readout(o, r, k_dir, v, r_k, gn_w, gn_b, g):
    B, T = o.shape[:2]
    mean = jnp.mean(o, axis=-1, keepdims=True)
    var = jnp.mean(jnp.square(o - mean), axis=-1, keepdims=True)
    on = ((o - mean) * lax.rsqrt(var + GN_EPS)).reshape(B, T, D_A) * gn_w + gn_b
    bonus = jnp.einsum('bthn,btdhn,hn->bth', r, k_dir, r_k)[..., None] * v
    return ((on + bonus.reshape(B, T, D_A)) * jax.nn.silu(g.astype(jnp.float32))).astype(g.dtype)


def rwkv7_mixer(f, f_c, g, g_c, mu, w0, w_up, a0, a_up, k_k, k_a, r_k, gn_w, gn_b, ctx_out):
    r, v, kk, decay, k_dir, a = rwkv7_prepare(f, mu, w0, w_up, a0, a_up, k_k, k_a)
    r_c, v_c, kk_c, decay_c, k_dir_c, a_c = rwkv7_prepare(f_c, mu, w0, w_up, a0, a_up, k_k, k_a)
    B = r.shape[0]
    outs, outs_c = [], []
    for d, rev in enumerate(SCAN_DIRECTIONS):
        S0 = jnp.zeros((B, H_A, HEAD_A, HEAD_A), jnp.float32)
        S_c, o_c = rwkv7_scan(S0, r_c, decay_c[:, :, d], k_dir_c[:, :, d], v_c, kk_c, a_c[:, :, d], rev)
        _, o = rwkv7_scan(S_c, r, decay[:, :, d], k_dir[:, :, d], v, kk, a[:, :, d], rev)
        outs.append(o)
        outs_c.append(o_c)
    y = rwkv7_readout(outs[0] + outs[1], r, k_dir, v, r_k, gn_w, gn_b, g)
    y_c = rwkv7_readout(outs_c[0] + outs_c[1], r_c, k_dir_c, v_c, r_k, gn_w, gn_b, g_c) if ctx_out else None
    return y, y_c


def neighbourhood_attention(q, k, v, kc, vc, rpb):
    B, S, H, Dh = q.shape
    rows = S // GRID_W
    kh = min(NA_WIN_H, rows)
    n_loc = kh * NA_WIN_W
    scale = Dh ** -0.5
    qg = q.reshape(B, rows, GRID_W, H, Dh)
    kg = k.reshape(B, rows, GRID_W, H, Dh)
    vg = v.reshape(B, rows, GRID_W, H, Dh)
    cols = jnp.arange(GRID_W)
    col_start = jnp.clip(cols - NA_WIN_W // 2, 0, GRID_W - NA_WIN_W)
    col_idx = col_start[:, None] + jnp.arange(NA_WIN_W)[None, :]
    dx = col_idx - cols[:, None] + (NA_WIN_W - 1)

    def row_block(y):
        y0 = jnp.clip(y - kh // 2, 0, rows - kh)
        k_nb = lax.dynamic_slice_in_dim(kg, y0, kh, axis=1)[:, :, col_idx]
        v_nb = lax.dynamic_slice_in_dim(vg, y0, kh, axis=1)[:, :, col_idx]
        qy = lax.dynamic_index_in_dim(qg, y, axis=1, keepdims=False)
        dy = y0 + jnp.arange(kh) - y + (NA_WIN_H - 1)
        bias = rpb[:, dy[None, :, None], dx[:, None, :]].reshape(H, GRID_W, n_loc)
        s_loc = jnp.einsum('bwhd,brwkhd->bhwrk', qy, k_nb).reshape(B, H, GRID_W, n_loc)
        s_ctx = jnp.einsum('bwhd,bchd->bhwc', qy, kc)
        s = jnp.concatenate([s_loc.astype(jnp.float32) * scale + bias.astype(jnp.float32),
                             s_ctx.astype(jnp.float32) * scale], axis=-1)
        p = jax.nn.softmax(s, axis=-1).astype(v.dtype)
        p_loc = p[..., :n_loc].reshape(B, H, GRID_W, kh, NA_WIN_W)
        return (jnp.einsum('bhwrk,brwkhd->bwhd', p_loc, v_nb)
                + jnp.einsum('bhwc,bchd->bwhd', p[..., n_loc:], vc))

    o = lax.map(row_block, jnp.arange(rows))
    return jnp.moveaxis(o, 0, 1).reshape(B, S, H, Dh)


def ctx_attention(qc, kc, vc):
    s = jnp.einsum('bqhd,bkhd->bhqk', qc, kc).astype(jnp.float32) * (qc.shape[-1] ** -0.5)
    p = jax.nn.softmax(s, axis=-1).astype(vc.dtype)
    return jnp.einsum('bhqk,bkhd->bqhd', p, vc)


def even_mixer(h, hc, w_in, mu, w0, w_up, a0, a_up, k_k, k_a, r_k, gn_w, gn_b, rpb, ctx_out):
    fa, ga, qb, kb, vb, gb = jnp.split(h @ w_in, EV_SPLITS, axis=-1)
    fa_c, ga_c, qb_c, kb_c, vb_c, gb_c = jnp.split(hc @ w_in, EV_SPLITS, axis=-1)
    ya, ya_c = rwkv7_mixer(fa, fa_c, ga, ga_c, mu, w0, w_up, a0, a_up, k_k, k_a, r_k, gn_w, gn_b, ctx_out)
    kc, vc = heads(kb_c, HEAD_B), heads(vb_c, HEAD_B)
    ob = neighbourhood_attention(heads(qb, HEAD_B), heads(kb, HEAD_B), heads(vb, HEAD_B), kc, vc, rpb)
    yb = ob.reshape(h.shape[0], h.shape[1], D_B) * jax.nn.silu(gb)
    y = jnp.concatenate([ya, yb.astype(ya.dtype)], axis=-1)
    if not ctx_out:
        return y, None
    ob_c = ctx_attention(heads(qb_c, HEAD_B), kc, vc)
    yb_c = ob_c.reshape(hc.shape[0], hc.shape[1], D_B) * jax.nn.silu(gb_c)
    return y, jnp.concatenate([ya_c, yb_c.astype(ya_c.dtype)], axis=-1)


def centred_depthwise_conv(x, w, b):
    out = lax.conv_general_dilated(x, w[:, None, :].astype(x.dtype), window_strides=(1,),
                                   padding=[(CONV_LEFT, CONV_W - 1 - CONV_LEFT)],
                                   dimension_numbers=('NWC', 'WIO', 'NWC'),
                                   feature_group_count=x.shape[-1])
    return out + b


def rglru_coeffs(u, wa, ba, wx, bx, lam):
    B, T, _ = u.shape
    ub = u.reshape(B, T, RG_BLOCKS, RG_BS)
    gate_r = jax.nn.sigmoid(jnp.einsum('bthi,hij->bthj', ub, wa).reshape(B, T, D_C) + ba)
    gate_i = jax.nn.sigmoid(jnp.einsum('bthi,hij->bthj', ub, wx).reshape(B, T, D_C) + bx)
    log_a = -RGLRU_C * gate_r * jax.nn.softplus(-lam)
    a = jnp.exp(log_a)
    b = jnp.sqrt(-jnp.expm1(2.0 * log_a)) * (gate_i * u)
    return a, b


def linear_scan(a, b, h0, reverse):
    def combine(e1, e2):
        a1, b1 = e1
        a2, b2 = e2
        return a1 * a2, a2 * b1 + b2
    a_cum, h = lax.associative_scan(combine, (a, b), reverse=reverse, axis=1)
    return h + a_cum * h0[:, None]


def rglru_mixer(h, hc, w_in, conv_w, conv_b, ga_w, ga_b, gx_w, gx_b, lam, ctx_out):
    xr, g = jnp.split(h @ w_in, 2, axis=-1)
    xr_c, g_c = jnp.split(hc @ w_in, 2, axis=-1)
    u = centred_depthwise_conv(xr, conv_w, conv_b).astype(jnp.float32)
    u_c = centred_depthwise_conv(xr_c, conv_w, conv_b).astype(jnp.float32)
    ys, ys_c = [], []
    for d, rev in enumerate(SCAN_DIRECTIONS):
        a_c, b_c = rglru_coeffs(u_c, ga_w[d], ga_b[d], gx_w[d], gx_b[d], lam[d])
        h_c = linear_scan(a_c, b_c, jnp.zeros_like(u_c[:, 0]), rev)
        h0 = h_c[:, 0] if rev else h_c[:, -1]
        a, b = rglru_coeffs(u, ga_w[d], ga_b[d], gx_w[d], gx_b[d], lam[d])
        ys.append(linear_scan(a, b, h0, rev))
        ys_c.append(h_c)
    y = ((ys[0] + ys[1]) * jax.nn.silu(g.astype(jnp.float32))).astype(h.dtype)
    if not ctx_out:
        return y, None
    y_c = ((ys_c[0] + ys_c[1]) * jax.nn.silu(g_c.astype(jnp.float32))).astype(hc.dtype)
    return y, y_c


def setup_inputs(seed: int = 0) -> dict:
    key = jax.random.key(seed)
    ks = iter(jax.random.split(key, 40))
    nrm = lambda shape, s: s * jax.random.normal(next(ks), shape, jnp.float32)
    uni = lambda shape, lo, hi: jax.random.uniform(next(ks), shape, jnp.float32, lo, hi)
    D = D_MODEL
    lam_u = uni((N_ODD, 2, D_C), 0.9, 0.999) ** (1.0 / RGLRU_C)
    return {
        "x": nrm((BATCH, SEQ, D), 1.0),
        "c": nrm((BATCH, D), 1.0),
        "ctx": nrm((BATCH, CTX_LEN, D), 1.0),
        "c_ctx": nrm((D,), 1.0),
        "mod_w": nrm((DEPTH, D, 3 * D), 0.5 * D ** -0.5),
        "mod_b": nrm((DEPTH, 3 * D), 0.02),
        "norm_pre": 1.0 + nrm((DEPTH, D), 0.05),
        "norm_post": 1.0 + nrm((DEPTH, D), 0.05),
        "ev_w_in": nrm((N_EVEN, D, EV_IN), D ** -0.5),
        "ev_mu": uni((N_EVEN, 2, A_SHIFTED), 0.0, 0.5),
        "ev_w0": jnp.linspace(-6.0, -0.5, D_A)[None, None, :] + nrm((N_EVEN, 2, D_A), 0.3),
        "ev_w_up": nrm((N_EVEN, 2, R_W, D_A), 0.5 * R_W ** -0.5),
        "ev_a0": nrm((N_EVEN, 2, D_A), 0.3),
        "ev_a_up": nrm((N_EVEN, 2, R_A, D_A), 0.3 * R_A ** -0.5),
        "ev_k_k": 0.85 + nrm((N_EVEN, D_A), 0.05),
        "ev_k_a": 1.0 + nrm((N_EVEN, D_A), 0.05),
        "ev_r_k": nrm((N_EVEN, H_A, HEAD_A), 0.1),
        "ev_gn_w": 1.0 + nrm((N_EVEN, D_A), 0.05),
        "ev_gn_b": nrm((N_EVEN, D_A), 0.02),
        "ev_rpb": nrm((N_EVEN, H_B, 2 * NA_WIN_H - 1, 2 * NA_WIN_W - 1), 0.5),
        "ev_w_out": nrm((N_EVEN, D_A + D_B, D), (D_A + D_B) ** -0.5),
        "od_w_in": nrm((N_ODD, D, 2 * D_C), D ** -0.5),
        "od_conv_w": nrm((N_ODD, CONV_W, D_C), CONV_W ** -0.5),
        "od_conv_b": nrm((N_ODD, D_C), 0.02),
        "od_gate_a_w": nrm((N_ODD, 2, RG_BLOCKS, RG_BS, RG_BS), RG_BS ** -0.5),
        "od_gate_a_b": nrm((N_ODD, 2, D_C), 0.02),
        "od_gate_x_w": nrm((N_ODD, 2, RG_BLOCKS, RG_BS, RG_BS), RG_BS ** -0.5),
        "od_gate_x_b": nrm((N_ODD, 2, D_C), 0.02),
        "od_lambda": jnp.log(lam_u) - jnp.log1p(-lam_u),
        "od_w_out": nrm((N_ODD, D_C, D), D_C ** -0.5),
    }


def reference(x, c, ctx, c_ctx, mod_w, mod_b, norm_pre, norm_post, ev_w_in, ev_mu, ev_w0, ev_w_up,
              ev_a0, ev_a_up, ev_k_k, ev_k_a, ev_r_k, ev_gn_w, ev_gn_b, ev_rpb, ev_w_out, od_w_in,
              od_conv_w, od_conv_b, od_gate_a_w, od_gate_a_b, od_gate_x_w, od_gate_x_b, od_lambda,
              od_w_out):
    xc = ctx
    for layer in range(DEPTH):
        ctx_out = layer < DEPTH - 1
        i = layer // 2
        shift, scale, gate = jnp.split(jax.nn.silu(c) @ mod_w[layer] + mod_b[layer], 3, axis=-1)
        shift_c, scale_c, gate_c = jnp.split(jax.nn.silu(c_ctx) @ mod_w[layer] + mod_b[layer], 3, axis=-1)
        h = rmsnorm(x, norm_pre[layer]) * (1.0 + scale[:, None]) + shift[:, None]
        hc = rmsnorm(xc, norm_pre[layer]) * (1.0 + scale_c) + shift_c
        if layer % 2 == 0:
            y, yc = even_mixer(h, hc, ev_w_in[i], ev_mu[i], ev_w0[i], ev_w_up[i], ev_a0[i], ev_a_up[i],
                               ev_k_k[i], ev_k_a[i], ev_r_k[i], ev_gn_w[i], ev_gn_b[i], ev_rpb[i], ctx_out)
            w_out = ev_w_out[i]
        else:
            y, yc = rglru_mixer(h, hc, od_w_in[i], od_conv_w[i], od_conv_b[i], od_gate_a_w[i], od_gate_a_b[i],
                                od_gate_x_w[i], od_gate_x_b[i], od_lambda[i], ctx_out)
            w_out = od_w_out[i]
        x = x + gate[:, None] * rmsnorm(y @ w_out, norm_post[layer])
        if ctx_out:
            xc = xc + gate_c * rmsnorm(yc @ w_out, norm_post[layer])
    return x
```

```cpp
#include <hip/hip_runtime.h>
#include <hip/hip_bf16.h>
#include <hip/hip_cooperative_groups.h>
#include <cstdio>
namespace cg = cooperative_groups;

typedef unsigned short u16;
using bf16x8 = __attribute__((ext_vector_type(8))) short;
using f32x4 = __attribute__((ext_vector_type(4))) float;

constexpr int D = 2048, NB = 4, SEQ = 4096, CTX = 256;
constexpr int MLAT = NB * SEQ;
constexpr int MCTX = NB * CTX;
constexpr int MTOT = MLAT + MCTX;
constexpr int EV_IN = 8448, OD_IN = 5120, DC = 2560, DA = 1024;
constexpr int AB_R1 = 11264;
constexpr int NCH = 136;
#define HALF_MASK 0
constexpr int SMEM_BYTES = 72704;

struct Params {
  const float *x, *c, *ctx, *c_ctx, *mod_w, *mod_b, *norm_pre, *norm_post;
  const float *ev_w_in, *ev_mu, *ev_w0, *ev_w_up, *ev_a0, *ev_a_up, *ev_k_k, *ev_k_a, *ev_r_k, *ev_gn_w,
      *ev_gn_b, *ev_rpb, *ev_w_out;
  const float *od_w_in, *od_conv_w, *od_conv_b, *od_ga_w, *od_ga_b, *od_gx_w, *od_gx_b, *od_lambda, *od_w_out;
  float* out;
  u16 *wt_ev_in, *wt_ev_out, *wt_od_in, *wt_od_out, *wt_gate;
  float *mod, *xc;
  u16 *h, *P, *y, *vtL, *vtC;
  float *z, *o_scan, *rk, *summ, *carry;
  int* cnt;
  unsigned *abA, *abB;
  unsigned* bar;
  int ph0, ph1;
};

__device__ __forceinline__ u16 f2bf(float f) {
  unsigned u = __float_as_uint(f);
  u += 0x7fffu + ((u >> 16) & 1u);
  return (u16)(u >> 16);
}
__device__ __forceinline__ float bf2f(u16 h) { return __uint_as_float(((unsigned)h) << 16); }
__device__ __forceinline__ float bflo(unsigned v) { return __uint_as_float(v << 16); }
__device__ __forceinline__ float bfhi(unsigned v) { return __uint_as_float(v & 0xffff0000u); }
__device__ __forceinline__ unsigned pack2(float a, float b) { return (unsigned)f2bf(a) | ((unsigned)f2bf(b) << 16); }
__device__ __forceinline__ float sigmoidf_(float x) { return __builtin_amdgcn_rcpf(1.f + __expf(-x)); }
__device__ __forceinline__ float siluf_(float x) { return x * __builtin_amdgcn_rcpf(1.f + __expf(-x)); }
__device__ __forceinline__ float softplusf_(float x) { return fmaxf(x, 0.f) + __logf(1.f + __expf(-fabsf(x))); }
__device__ __forceinline__ float tanhf_(float x) { return 1.f - 2.f * __builtin_amdgcn_rcpf(1.f + __expf(2.f * x)); }

__device__ __forceinline__ unsigned f2h_bits(float x) { _Float16 h = (_Float16)x; return (unsigned)__builtin_bit_cast(unsigned short, h); }
__device__ __forceinline__ float h2f_bits(unsigned b) { return (float)__builtin_bit_cast(_Float16, (unsigned short)(b & 0xffffu)); }
template <int CTRL>
__device__ __forceinline__ float dpp_f(float v) {
  return __int_as_float(__builtin_amdgcn_update_dpp(0, __float_as_int(v), CTRL, 0xf, 0xf, true));
}
__device__ __forceinline__ float red8(float v) {
  v += dpp_f<0xB1>(v);
  v += dpp_f<0x4E>(v);
  v += dpp_f<0x141>(v);
  return v;
}
__device__ __forceinline__ float red16(float v) {
  v = red8(v);
  v += dpp_f<0x140>(v);
  return v;
}
__device__ __forceinline__ float wave_sum(float v) {
#pragma unroll
  for (int o = 32; o > 0; o >>= 1) v += __shfl_xor(v, o);
  return v;
}

__device__ __forceinline__ void lds_barrier() {
  asm volatile("s_waitcnt lgkmcnt(0)\n\ts_barrier" ::: "memory");
}

__device__ __forceinline__ int lds_byte(int r, int c) {
  int st = (r >> 4) * 2 + (c >> 5), rr = r & 15, cc = c & 31, ob = rr * 64 + cc * 2;
  return st * 1024 + (ob ^ (((ob >> 9) & 1) << 5));
}

__device__ void transpose_job(int tid_, int bid_, int nblk_, const float* __restrict__ src, u16* __restrict__ dst, int K, int N, int nbatch,
                              size_t sstride, size_t dstride, int ldd, float* sm) {
  const int tid = tid_;
  const int tk = K / 32, tn = N / 32, per = tk * tn, total = per * nbatch;
  for (int t = bid_; t < total; t += nblk_) {
    int bi = t / per, r = t % per, kt = r / tn, nt = r % tn;
    const float* s = src + (size_t)bi * sstride + (size_t)(kt * 32) * N + nt * 32;
#pragma unroll
    for (int i = 0; i < 4; ++i) {
      int kk = (tid >> 5) + 8 * i, nn = tid & 31;
      sm[kk * 33 + nn] = s[(size_t)kk * N + nn];
    }
    __syncthreads();
    {
      int n = tid >> 3, kc = tid & 7;
      float v0 = sm[(kc * 4 + 0) * 33 + n], v1 = sm[(kc * 4 + 1) * 33 + n];
      float v2 = sm[(kc * 4 + 2) * 33 + n], v3 = sm[(kc * 4 + 3) * 33 + n];
      uint2 o;
      o.x = pack2(v0, v1);
      o.y = pack2(v2, v3);
      *(uint2*)(dst + (size_t)bi * dstride + (size_t)(nt * 32 + n) * ldd + kt * 32 + kc * 4) = o;
    }
    __syncthreads();
  }
}

__device__ void transpose_job64(int tid_, int bid_, int nblk_, const float* __restrict__ src, u16* __restrict__ dst, int K, int N,
                                int nbatch, size_t sstride, size_t dstride, int ldd, float* sm) {
  const int tid = tid_;
  const int tk = K / 64, tn = N / 64, per = tk * tn, total = per * nbatch;
  for (int t = bid_; t < total; t += nblk_) {
    int bi = t / per, r = t % per, kt = r / tn, nt = r % tn;
    const float* s = src + (size_t)bi * sstride + (size_t)(kt * 64) * N + nt * 64;
#pragma unroll
    for (int i = 0; i < 16; ++i) {
      int kk = (tid >> 6) + 4 * i, nn = tid & 63;
      sm[kk * 65 + nn] = s[(size_t)kk * N + nn];
    }
    __syncthreads();
    {
      int n = tid >> 2, kc = tid & 3;
      unsigned o[8];
#pragma unroll
      for (int e = 0; e < 8; ++e) o[e] = pack2(sm[(kc * 16 + 2 * e) * 65 + n], sm[(kc * 16 + 2 * e + 1) * 65 + n]);
      u16* d = dst + (size_t)bi * dstride + (size_t)(nt * 64 + n) * ldd + kt * 64 + kc * 16;
      *(uint4*)(d) = make_uint4(o[0], o[1], o[2], o[3]);
      *(uint4*)(d + 8) = make_uint4(o[4], o[5], o[6], o[7]);
    }
    __syncthreads();
  }
}

__device__ void mod_phase(int tid_, int bid_, int nblk_, const Params& p, char* smem, int item0, int item1) {
  if (item0 + bid_ >= item1) return;
  float* sC = (float*)smem;
  float* sRed = sC + 5 * 2048;
  const int tid = tid_;
  for (int i = tid; i < 5 * 2048; i += 256) {
    int r = i / 2048, k = i % 2048;
    float v = (r < 4) ? p.c[r * 2048 + k] : p.c_ctx[k];
    sC[i] = siluf_(v);
  }
  __syncthreads();
  for (int item = item0 + bid_; item < item1; item += nblk_) {
    int layer = item / 96, col0 = (item % 96) * 64;
    const float* W = p.mod_w + (size_t)layer * 2048 * 6144;
    int kg = tid >> 4, cl = tid & 15, col = col0 + cl * 4;
    float acc[5][4];
#pragma unroll
    for (int r = 0; r < 5; ++r)
#pragma unroll
      for (int e = 0; e < 4; ++e) acc[r][e] = 0.f;
    for (int k = kg * 128; k < kg * 128 + 128; ++k) {
      float4 w4 = *(const float4*)(W + (size_t)k * 6144 + col);
#pragma unroll
      for (int r = 0; r < 5; ++r) {
        float s = sC[r * 2048 + k];
        acc[r][0] += s * w4.x; acc[r][1] += s * w4.y; acc[r][2] += s * w4.z; acc[r][3] += s * w4.w;
      }
    }
#pragma unroll
    for (int r = 0; r < 5; ++r)
#pragma unroll
      for (int e = 0; e < 4; ++e) sRed[(kg * 5 + r) * 64 + cl * 4 + e] = acc[r][e];
    __syncthreads();
    for (int o = tid; o < 320; o += 256) {
      int r = o / 64, cc = o % 64;
      float s = 0.f;
#pragma unroll
      for (int g = 0; g < 16; ++g) s += sRed[(g * 5 + r) * 64 + cc];
      p.mod[(layer * 5 + r) * 6144 + col0 + cc] = s + p.mod_b[layer * 6144 + col0 + cc];
    }
    __syncthreads();
  }
}

__device__ void norm_phase(int tid_, int bid_, int nblk_, const Params& p, int lprev, int lnext) {
  const int lane = tid_ & 63, w = __builtin_amdgcn_readfirstlane(tid_ >> 6);
  const int gw = bid_ * 4 + w, nw = nblk_ * 4;
  for (int row = gw; row < MTOT; row += nw) {
    const bool isctx = row >= MLAT;
    if (isctx && lprev == 3) continue;
    const int mrow = isctx ? 4 : row / SEQ;
    const float* xold;
    float* xnew;
    if (!isctx) {
      xold = (lprev <= 0 ? p.x : p.out) + (size_t)row * D;
      xnew = p.out + (size_t)row * D;
    } else {
      int cr = row - MLAT;
      xold = (lprev <= 0 ? p.ctx : p.xc) + (size_t)cr * D;
      xnew = p.xc + (size_t)cr * D;
    }
    float xv[32];
#pragma unroll
    for (int i = 0; i < 8; ++i) {
      float4 v = *(const float4*)(xold + i * 256 + lane * 4);
      xv[i * 4 + 0] = v.x; xv[i * 4 + 1] = v.y; xv[i * 4 + 2] = v.z; xv[i * 4 + 3] = v.w;
    }
    if (lprev >= 0) {
      const float* zr = p.z + (size_t)row * D;
      float zv[32];
      float ss = 0.f;
#pragma unroll
      for (int i = 0; i < 8; ++i) {
        float4 v = *(const float4*)(zr + i * 256 + lane * 4);
        zv[i * 4 + 0] = v.x; zv[i * 4 + 1] = v.y; zv[i * 4 + 2] = v.z; zv[i * 4 + 3] = v.w;
        ss += v.x * v.x + v.y * v.y + v.z * v.z + v.w * v.w;
      }
      ss = wave_sum(ss);
      float rs = rsqrtf(ss * (1.f / 2048.f) + 1e-6f);
      const float* gate = p.mod + (lprev * 5 + mrow) * 6144 + 4096;
      const float* np = p.norm_post + lprev * D;
#pragma unroll
      for (int i = 0; i < 8; ++i) {
        int idx = i * 256 + lane * 4;
        float4 g4 = *(const float4*)(gate + idx);
        float4 n4 = *(const float4*)(np + idx);
        xv[i * 4 + 0] += g4.x * (zv[i * 4 + 0] * rs * n4.x);
        xv[i * 4 + 1] += g4.y * (zv[i * 4 + 1] * rs * n4.y);
        xv[i * 4 + 2] += g4.z * (zv[i * 4 + 2] * rs * n4.z);
        xv[i * 4 + 3] += g4.w * (zv[i * 4 + 3] * rs * n4.w);
        float4 o;
        o.x = xv[i * 4 + 0]; o.y = xv[i * 4 + 1]; o.z = xv[i * 4 + 2]; o.w = xv[i * 4 + 3];
        *(float4*)(xnew + idx) = o;
      }
    }
    if (lnext <= 3) {
      float ss = 0.f;
#pragma unroll
      for (int i = 0; i < 32; ++i) ss += xv[i] * xv[i];
      ss = wave_sum(ss);
      float rs = rsqrtf(ss * (1.f / 2048.f) + 1e-6f);
      const float* shift = p.mod + (lnext * 5 + mrow) * 6144;
      const float* scale = shift + 2048;
      const float* npre = p.norm_pre + lnext * D;
      u16* hr = p.h + (size_t)row * D;
#pragma unroll
      for (int i = 0; i < 8; ++i) {
        int idx = i * 256 + lane * 4;
        float4 s4 = *(const float4*)(shift + idx);
        float4 c4 = *(const float4*)(scale + idx);
        float4 n4 = *(const float4*)(npre + idx);
        float h0 = xv[i * 4 + 0] * rs * n4.x * (1.f + c4.x) + s4.x;
        float h1 = xv[i * 4 + 1] * rs * n4.y * (1.f + c4.y) + s4.y;
        float h2 = xv[i * 4 + 2] * rs * n4.z * (1.f + c4.z) + s4.z;
        float h3 = xv[i * 4 + 3] * rs * n4.w * (1.f + c4.w) + s4.w;
        uint2 o;
        o.x = pack2(h0, h1);
        o.y = pack2(h2, h3);
        *(uint2*)(hr + idx) = o;
      }
    }
  }
}

template <int MODE>
__device__ void gemm_phase(int tid_, int bid_, int nblk_, const u16* __restrict__ A, int lda, const u16* __restrict__ Bt, int K, int N, void* Cout,
                           int ldc, u16* vtL, u16* vtC, char* smem, int MT = MTOT / 128) {
  const int tid = tid_, lane = tid & 63, wid = __builtin_amdgcn_readfirstlane(tid >> 6);
  const int wm = wid >> 1, wn = wid & 1, fr = lane & 15, fq = lane >> 4;
  const int NT = N / 128, ntiles = MT * NT, nk = K / 64;
  const int GM = 8, nig = GM * NT;
  const int pr = tid >> 3, pc8 = tid & 7;
  const int bpx = nblk_ >> 3;
  for (int it = 0; (it * 8) * bpx < ntiles; ++it) {
    const int tile = (it * 8 + (bid_ & 7)) * bpx + (bid_ >> 3);
    if (tile >= ntiles) continue;
    int gid = tile / nig, fm = gid * GM;
    int pm = fm + (tile % nig) % GM, pn = (tile % nig) / GM;
    const int row0 = pm * 128, col0 = pn * 128;
    const u16* gA = A + (size_t)(row0 + pr) * lda + pc8 * 8;
    const u16* gB = Bt + (size_t)(col0 + pr) * K + pc8 * 8;
    f32x4 acc[4][4];
#pragma unroll
    for (int i = 0; i < 4; ++i)
#pragma unroll
      for (int j = 0; j < 4; ++j) acc[i][j] = f32x4{0.f, 0.f, 0.f, 0.f};
    const u16* srcA[4];
    const u16* srcB[4];
#pragma unroll
    for (int i = 0; i < 4; ++i) {
      int bb = tid * 16 + i * 4096;
      int st = bb >> 10, sb = bb & 1023, swz = sb ^ (((sb >> 9) & 1) << 5);
      int R = (st >> 1) * 16 + (swz >> 6), Cc = (st & 1) * 32 + ((swz & 63) >> 1);
      srcA[i] = A + (size_t)(row0 + R) * lda + Cc;
      srcB[i] = Bt + (size_t)(col0 + R) * K + Cc;
    }
    auto stage = [&](int kt, int BUF) {
#pragma unroll
      for (int i = 0; i < 4; ++i) {
        char* la = smem + BUF * 32768 + tid * 16 + i * 4096;
        __builtin_amdgcn_global_load_lds((const unsigned*)(srcA[i] + kt * 64),
                                         (__attribute__((address_space(3))) unsigned*)la, 16, 0, 0);
        __builtin_amdgcn_global_load_lds((const unsigned*)(srcB[i] + kt * 64),
                                         (__attribute__((address_space(3))) unsigned*)(la + 16384), 16, 0, 0);
      }
    };
    auto compute = [&](int BUF) {
      const char* sa = smem + BUF * 32768;
      const char* sb = sa + 16384;
      bf16x8 af[4][2], bfr[4][2];
#pragma unroll
      for (int ms = 0; ms < 4; ++ms)
#pragma unroll
        for (int ks = 0; ks < 2; ++ks)
          af[ms][ks] = *(const bf16x8*)(sa + lds_byte(wm * 64 + ms * 16 + fr, ks * 32 + fq * 8));
#pragma unroll
      for (int ns = 0; ns < 4; ++ns)
#pragma unroll
        for (int ks = 0; ks < 2; ++ks)
          bfr[ns][ks] = *(const bf16x8*)(sb + lds_byte(wn * 64 + ns * 16 + fr, ks * 32 + fq * 8));
      __builtin_amdgcn_s_setprio(1);
#pragma unroll
      for (int ks = 0; ks < 2; ++ks)
#pragma unroll
        for (int ms = 0; ms < 4; ++ms)
#pragma unroll
          for (int ns = 0; ns < 4; ++ns)
            acc[ms][ns] = __builtin_amdgcn_mfma_f32_16x16x32_bf16(bfr[ns][ks], af[ms][ks], acc[ms][ns], 0, 0, 0);
      __builtin_amdgcn_s_setprio(0);
    };
    stage(0, 0);
    asm volatile("s_waitcnt vmcnt(0)" ::: "memory");
    lds_barrier();
    for (int kt = 0; kt < nk; ++kt) {
      if (kt + 1 < nk) stage(kt + 1, (kt + 1) & 1);
      compute(kt & 1);
      asm volatile("s_waitcnt vmcnt(0)" ::: "memory");
      lds_barrier();
    }
    const bool vt = (MODE == 1) && (col0 >= 6400) && (col0 < 7424);
#pragma unroll
    for (int ms = 0; ms < 4; ++ms) {
      const int m = row0 + wm * 64 + ms * 16 + fr;
#pragma unroll
      for (int ns = 0; ns < 4; ++ns) {
        const int n = col0 + wn * 64 + ns * 16 + fq * 4;
        f32x4 v = acc[ms][ns];
        if (MODE == 2) {
          float4 o;
          o.x = v[0]; o.y = v[1]; o.z = v[2]; o.w = v[3];
          *(float4*)((float*)Cout + (size_t)m * ldc + n) = o;
        } else if (vt) {
          int cn = n - 6400;
          if (m < MLAT) {
            int b = m >> 12, t = m & 4095;
#pragma unroll
            for (int j = 0; j < 4; ++j) vtL[((size_t)(b * 1024 + cn + j)) * SEQ + t] = f2bf(v[j]);
          } else {
            int b = (m - MLAT) >> 8, t = (m - MLAT) & 255;
#pragma unroll
            for (int j = 0; j < 4; ++j) vtC[((size_t)(b * 1024 + cn + j)) * CTX + t] = f2bf(v[j]);
          }
        } else {
          uint2 o;
          o.x = pack2(v[0], v[1]);
          o.y = pack2(v[2], v[3]);
          *(uint2*)((u16*)Cout + (size_t)m * ldc + n) = o;
        }
      }
    }
  }
}

struct Pre {
  uint2 cur[5], prv[5], nxt[5];
};

__device__ __forceinline__ void chunk_info(int gc, int b, int dir, int& rowbase, int& T, int& tb) {
  int c;
  if (gc < 16) { rowbase = MLAT + b * CTX; T = CTX; c = gc; }
  else { rowbase = b * SEQ; T = SEQ; c = gc - 16; }
  tb = dir ? (T - 16 - c * 16) : (c * 16);
}

typedef float v2f __attribute__((ext_vector_type(2)));

typedef float v2f __attribute__((ext_vector_type(2)));

__device__ void rwkv_scan_item(int tid_, int bid_, int nblk_, const Params& p, int li, int item, char* smem) {
  const int half = item & 1, dir = (item >> 1) & 1, h = (item >> 2) & 15, b = item >> 6;
  const int tid = tid_, lane = tid & 63, w = __builtin_amdgcn_readfirstlane(tid >> 6);
  const int fr = lane & 15, fq = lane >> 4;
  float* sW = (float*)smem;
  float* sKK = sW + 1024;
  float* sKKA = sKK + 1024;
  float* sKD = sKKA + 1024;
  float* sR = sKD + 1024;
  float* sV = sR + 1024;
  float* sK = sV + 1024;
  float* sO = sK + 1024;
  u16* sAw = (u16*)(sO + 1024);
  u16* sAa = sAw + 16 * 72;
  float* sMu0 = (float*)(sAa + 16 * 72);
  float* sMu1 = sMu0 + 320;
  float* sKk = sMu1 + 320;
  float* sRk = sKk + 64;
  const u16* P = p.P;
  const int sA_s0 = tid >> 4, sA_cc0 = tid & 15;
  int goff[5];
  goff[0] = h * 64; goff[1] = 1024 + h * 64; goff[2] = 2048 + h * 64; goff[3] = 3072 + dir * 64; goff[4] = 3200 + dir * 64;
  __syncthreads();
  {
    const float* mu0 = p.ev_mu + (size_t)li * 2 * 3328;
    const float* mu1 = mu0 + 3328;
    for (int i = tid; i < 320; i += 256) {
      int g = i >> 6, c = i & 63;
      sMu0[i] = mu0[goff[g] + c];
      sMu1[i] = mu1[goff[g] + c];
    }
    if (tid < 64) {
      sKk[tid] = p.ev_k_k[li * DA + h * 64 + tid];
      sRk[tid] = p.ev_r_k[(li * 16 + h) * 64 + tid];
    }
  }
  const int keyB = 16 * w + fr;
  const float w0v = p.ev_w0[(li * 2 + dir) * DA + h * 64 + keyB];
  const float a0v = p.ev_a0[(li * 2 + dir) * DA + h * 64 + keyB];
  const float kav = p.ev_k_a[li * DA + h * 64 + keyB];
  bf16x8 bw[2], ba[2];
  {
    const float* wu = p.ev_w_up + (size_t)(li * 2 + dir) * 64 * DA + h * 64 + keyB;
    const float* au = p.ev_a_up + (size_t)(li * 2 + dir) * 64 * DA + h * 64 + keyB;
#pragma unroll
    for (int ks = 0; ks < 2; ++ks)
#pragma unroll
      for (int j = 0; j < 8; ++j) {
        int k = ks * 32 + fq * 8 + j;
        bw[ks][j] = (short)f2bf(wu[(size_t)k * DA]);
        ba[ks][j] = (short)f2bf(au[(size_t)k * DA]);
      }
  }
  const int rlC = 8 * w + (lane >> 3), ksC = lane & 7;
  const int vrowC = half * 32 + rlC;
  v2f S[4];
#pragma unroll
  for (int k = 0; k < 4; ++k) S[k] = v2f{0.f, 0.f};

  auto load_pre = [&](int gc, Pre& pre, int sA_s, int sA_cc) {
    int rowbase, T, tb;
    chunk_info(gc, b, dir, rowbase, T, tb);
    int t = dir ? (tb + 15 - sA_s) : (tb + sA_s);
    const u16* base = P + (size_t)(rowbase + t) * EV_IN + sA_cc * 4;
#pragma unroll
    for (int g = 0; g < 5; ++g) {
      pre.cur[g] = *(const uint2*)(base + goff[g]);
      pre.prv[g] = (t > 0) ? *(const uint2*)(base - EV_IN + goff[g]) : make_uint2(0u, 0u);
      pre.nxt[g] = (t < T - 1) ? *(const uint2*)(base + EV_IN + goff[g]) : make_uint2(0u, 0u);
    }
  };

  Pre pre;
  load_pre(0, pre, sA_s0, sA_cc0);
  __syncthreads();
  const int NGC = 16 + 256;
  for (int gc = 0; gc <= NGC; ++gc) {
    int sA_s = sA_s0, sA_cc = sA_cc0;
    asm volatile("" : "+v"(sA_s), "+v"(sA_cc));
    if (gc > 0) {
      int rowbase, T, tb;
      chunk_info(gc - 1, b, dir, rowbase, T, tb);
      if (tid < 128) {
        int s = tid >> 3, c4 = (tid & 7) * 4;
        int t = dir ? (tb + 15 - s) : (tb + s);
        float4 o4 = *(const float4*)(sO + s * 32 + c4);
        *(float4*)(p.o_scan + ((size_t)dir * MTOT + rowbase + t) * DA + h * 64 + half * 32 + c4) = o4;
      }
      if (half == ((gc - 1) & 1)) {
        int t = dir ? (tb + 15 - sA_s) : (tb + sA_s);
        size_t row = (size_t)(rowbase + t);
        float4 r4 = *(const float4*)(sR + sA_s * 64 + sA_cc * 4);
        float4 k4 = *(const float4*)(sKD + sA_s * 64 + sA_cc * 4);
        float4 q4 = *(const float4*)(sRk + sA_cc * 4);
        float s = r4.x * k4.x * q4.x + r4.y * k4.y * q4.y + r4.z * k4.z * q4.z + r4.w * k4.w * q4.w;
        s = red16(s);
        if (sA_cc == 0) p.rk[((size_t)dir * MTOT + row) * 16 + h] = s;
      }
    }
    if (gc == NGC) break;
    {
      float val[5][4];
#pragma unroll
      for (int g = 0; g < 5; ++g) {
        float4 m0 = *(const float4*)(sMu0 + g * 64 + sA_cc * 4);
        float4 m1 = *(const float4*)(sMu1 + g * 64 + sA_cc * 4);
        float c0 = bflo(pre.cur[g].x), c1 = bfhi(pre.cur[g].x), c2 = bflo(pre.cur[g].y), c3 = bfhi(pre.cur[g].y);
        float p0 = bflo(pre.prv[g].x), p1 = bfhi(pre.prv[g].x), p2 = bflo(pre.prv[g].y), p3 = bfhi(pre.prv[g].y);
        float n0 = bflo(pre.nxt[g].x), n1 = bfhi(pre.nxt[g].x), n2 = bflo(pre.nxt[g].y), n3 = bfhi(pre.nxt[g].y);
        val[g][0] = c0 + m0.x * (p0 - c0) + m1.x * (n0 - c0);
        val[g][1] = c1 + m0.y * (p1 - c1) + m1.y * (n1 - c1);
        val[g][2] = c2 + m0.z * (p2 - c2) + m1.z * (n2 - c2);
        val[g][3] = c3 + m0.w * (p3 - c3) + m1.w * (n3 - c3);
      }
      const int so = sA_s * 64 + sA_cc * 4;
      *(float4*)(sR + so) = make_float4(val[0][0], val[0][1], val[0][2], val[0][3]);
      *(float4*)(sK + so) = make_float4(val[1][0], val[1][1], val[1][2], val[1][3]);
      *(float4*)(sV + so) = make_float4(val[2][0], val[2][1], val[2][2], val[2][3]);
      float4 kk4 = *(const float4*)(sKk + sA_cc * 4);
      float q0 = val[1][0] * kk4.x, q1 = val[1][1] * kk4.y, q2 = val[1][2] * kk4.z, q3 = val[1][3] * kk4.w;
      float ss = red16(q0 * q0 + q1 * q1 + q2 * q2 + q3 * q3);
      float rn = rsqrtf(ss + 1e-12f);
      *(float4*)(sKK + so) = make_float4(q0 * rn, q1 * rn, q2 * rn, q3 * rn);
      uint2 tw, ta;
      tw.x = pack2(tanhf_(val[3][0]), tanhf_(val[3][1]));
      tw.y = pack2(tanhf_(val[3][2]), tanhf_(val[3][3]));
      ta.x = pack2(val[4][0], val[4][1]);
      ta.y = pack2(val[4][2], val[4][3]);
      *(uint2*)(sAw + sA_s * 72 + sA_cc * 4) = tw;
      *(uint2*)(sAa + sA_s * 72 + sA_cc * 4) = ta;
    }
    lds_barrier();
    if (gc + 1 < NGC) load_pre(gc + 1, pre, sA_s, sA_cc);
    {
      f32x4 dw = {0.f, 0.f, 0.f, 0.f}, da = {0.f, 0.f, 0.f, 0.f};
#pragma unroll
      for (int ks = 0; ks < 2; ++ks) {
        bf16x8 aw = *(const bf16x8*)(sAw + fr * 72 + ks * 32 + fq * 8);
        bf16x8 aa = *(const bf16x8*)(sAa + fr * 72 + ks * 32 + fq * 8);
        dw = __builtin_amdgcn_mfma_f32_16x16x32_bf16(aw, bw[ks], dw, 0, 0, 0);
        da = __builtin_amdgcn_mfma_f32_16x16x32_bf16(aa, ba[ks], da, 0, 0, 0);
      }
#pragma unroll
      for (int j = 0; j < 4; ++j) {
        int s = fq * 4 + j;
        float xw = dw[j] + w0v;
        float dec = __expf(-0.60653066f * sigmoidf_(xw));
        float a = sigmoidf_(a0v + da[j]);
        float kx = sK[s * 64 + keyB], kkx = sKK[s * 64 + keyB];
        sW[s * 64 + keyB] = dec;
        sKD[s * 64 + keyB] = kx * (1.f + (a - 1.f) * kav);
        sKKA[s * 64 + keyB] = kkx * a;
      }
    }
    lds_barrier();
    {
      float4 cur[10], nxt[10];
      float vcur, vnxt;
      {
        const int o8 = ksC * 8;
        cur[0] = *(const float4*)(sKK + o8); cur[1] = *(const float4*)(sKK + o8 + 4);
        cur[2] = *(const float4*)(sW + o8); cur[3] = *(const float4*)(sW + o8 + 4);
        cur[4] = *(const float4*)(sKKA + o8); cur[5] = *(const float4*)(sKKA + o8 + 4);
        cur[6] = *(const float4*)(sKD + o8); cur[7] = *(const float4*)(sKD + o8 + 4);
        cur[8] = *(const float4*)(sR + o8); cur[9] = *(const float4*)(sR + o8 + 4);
        vcur = sV[vrowC];
      }
#pragma unroll
      for (int s = 0; s < 16; ++s) {
        if (s + 1 < 16) {
          const int o8 = (s + 1) * 64 + ksC * 8;
          nxt[0] = *(const float4*)(sKK + o8); nxt[1] = *(const float4*)(sKK + o8 + 4);
          nxt[2] = *(const float4*)(sW + o8); nxt[3] = *(const float4*)(sW + o8 + 4);
          nxt[4] = *(const float4*)(sKKA + o8); nxt[5] = *(const float4*)(sKKA + o8 + 4);
          nxt[6] = *(const float4*)(sKD + o8); nxt[7] = *(const float4*)(sKD + o8 + 4);
          nxt[8] = *(const float4*)(sR + o8); nxt[9] = *(const float4*)(sR + o8 + 4);
          vnxt = sV[(s + 1) * 64 + vrowC];
        }
        v2f kk[4] = {v2f{cur[0].x, cur[0].y}, v2f{cur[0].z, cur[0].w}, v2f{cur[1].x, cur[1].y}, v2f{cur[1].z, cur[1].w}};
        v2f ww[4] = {v2f{cur[2].x, cur[2].y}, v2f{cur[2].z, cur[2].w}, v2f{cur[3].x, cur[3].y}, v2f{cur[3].z, cur[3].w}};
        v2f ka[4] = {v2f{cur[4].x, cur[4].y}, v2f{cur[4].z, cur[4].w}, v2f{cur[5].x, cur[5].y}, v2f{cur[5].z, cur[5].w}};
        v2f kd[4] = {v2f{cur[6].x, cur[6].y}, v2f{cur[6].z, cur[6].w}, v2f{cur[7].x, cur[7].y}, v2f{cur[7].z, cur[7].w}};
        v2f rr[4] = {v2f{cur[8].x, cur[8].y}, v2f{cur[8].z, cur[8].w}, v2f{cur[9].x, cur[9].y}, v2f{cur[9].z, cur[9].w}};
        v2f a0 = S[0] * kk[0], a1 = S[1] * kk[1];
        a0 = __builtin_elementwise_fma(S[2], kk[2], a0);
        a1 = __builtin_elementwise_fma(S[3], kk[3], a1);
        a0 += a1;
        const float sa = red8(a0.x + a0.y);
        const v2f nsa = v2f{-sa, -sa}, vv = v2f{vcur, vcur};
#pragma unroll
        for (int k = 0; k < 4; ++k) {
          v2f t = S[k] * ww[k];
          t = __builtin_elementwise_fma(nsa, ka[k], t);
          S[k] = __builtin_elementwise_fma(vv, kd[k], t);
        }
        v2f o0 = S[0] * rr[0], o1 = S[1] * rr[1];
        o0 = __builtin_elementwise_fma(S[2], rr[2], o0);
        o1 = __builtin_elementwise_fma(S[3], rr[3], o1);
        o0 += o1;
        const float ov = red8(o0.x + o0.y);
        sO[s * 32 + rlC] = ov;
        if (s + 1 < 16) {
#pragma unroll
          for (int q = 0; q < 10; ++q) cur[q] = nxt[q];
          vcur = vnxt;
        }
      }
    }
    lds_barrier();
  }
}

__device__ void natten_tile(int tid_, int bid_, int nblk_, const Params& p, int li, int wt) {
  const int lane = tid_ & 63, fr = lane & 15, fq = lane >> 4;
  const u16* P = p.P;
  int b, h, y = 0, x0 = 0, nloc;
  size_t qrow0;
  if (wt < 16384) {
    int xg = wt & 3; y = (wt >> 2) & 63; h = (wt >> 8) & 15; b = wt >> 12;
    x0 = xg * 16; nloc = 8;
    qrow0 = (size_t)b * SEQ + y * 64 + x0;
  } else {
    int t2 = wt - 16384;
    int qg = t2 & 15; h = (t2 >> 4) & 15; b = t2 >> 8;
    nloc = 0;
    qrow0 = (size_t)MLAT + b * CTX + qg * 16;
  }
  const int y0 = min(max(y - 4, 0), 56);
  const int c0 = (x0 == 0) ? 0 : (x0 == 16 ? 8 : (x0 == 32 ? 24 : 32));
  const int xq = x0 + fr;
  const int cs = min(max(xq - 8, 0), 48);
  const float* rpb = p.ev_rpb + (size_t)(li * 16 + h) * 15 * 31;
  bf16x8 bq[2];
  {
    const u16* qp = P + (qrow0 + fr) * EV_IN + 4352 + h * 64 + fq * 8;
    bq[0] = *(const bf16x8*)(qp);
    bq[1] = *(const bf16x8*)(qp + 32);
  }
  const int nblk = nloc + 8;
  auto key_base = [&](int kb) -> size_t {
    return (kb < nloc) ? ((size_t)b * SEQ + (y0 + kb) * 64 + c0) : ((size_t)MLAT + b * CTX + (kb - nloc) * 32);
  };
  auto scores = [&](int kb, f32x4& sa, f32x4& sb) {
    size_t kr = key_base(kb);
    const u16* kp = P + (kr + fr) * EV_IN + 5376 + h * 64 + fq * 8;
    bf16x8 a0 = *(const bf16x8*)(kp);
    bf16x8 a1 = *(const bf16x8*)(kp + 32);
    bf16x8 a2 = *(const bf16x8*)(kp + (size_t)16 * EV_IN);
    bf16x8 a3 = *(const bf16x8*)(kp + (size_t)16 * EV_IN + 32);
    sa = f32x4{0.f, 0.f, 0.f, 0.f};
    sb = f32x4{0.f, 0.f, 0.f, 0.f};
    sa = __builtin_amdgcn_mfma_f32_16x16x32_bf16(a0, bq[0], sa, 0, 0, 0);
    sa = __builtin_amdgcn_mfma_f32_16x16x32_bf16(a1, bq[1], sa, 0, 0, 0);
    sb = __builtin_amdgcn_mfma_f32_16x16x32_bf16(a2, bq[0], sb, 0, 0, 0);
    sb = __builtin_amdgcn_mfma_f32_16x16x32_bf16(a3, bq[1], sb, 0, 0, 0);
    if (kb < nloc) {
      const float* rb = rpb + (y0 + kb - y + 7) * 31;
#pragma unroll
      for (int j = 0; j < 4; ++j) {
        int kc = c0 + fq * 4 + j;
        int kc2 = kc + 16;
        bool v1 = (kc >= cs) && (kc < cs + 16);
        bool v2 = (kc2 >= cs) && (kc2 < cs + 16);
        float b1 = v1 ? rb[kc - xq + 15] : 0.f;
        float b2 = v2 ? rb[kc2 - xq + 15] : 0.f;
        sa[j] = v1 ? sa[j] * 0.125f + b1 : -1e30f;
        sb[j] = v2 ? sb[j] * 0.125f + b2 : -1e30f;
      }
    } else {
#pragma unroll
      for (int j = 0; j < 4; ++j) { sa[j] *= 0.125f; sb[j] *= 0.125f; }
    }
  };
  const float THR = 0.f;
  float mref = -1e30f;
  f32x4 O[4];
#pragma unroll
  for (int nt = 0; nt < 4; ++nt) O[nt] = f32x4{0.f, 0.f, 0.f, 0.f};
  float lsum = 0.f;
#pragma unroll 2
  for (int kb = 0; kb < nblk; ++kb) {
    f32x4 sa, sb;
    scores(kb, sa, sb);
    float bm = fmaxf(fmaxf(fmaxf(sa[0], sa[1]), fmaxf(sa[2], sa[3])), fmaxf(fmaxf(sb[0], sb[1]), fmaxf(sb[2], sb[3])));
    if (__any(bm > mref + THR)) {
      bm = fmaxf(bm, __shfl_xor(bm, 16));
      bm = fmaxf(bm, __shfl_xor(bm, 32));
      const float mnew = fmaxf(mref, bm);
      const float f = __expf(mref - mnew);
      lsum *= f;
#pragma unroll
      for (int j = 0; j < 4; ++j) {
        const float fj = __shfl(f, fq * 4 + j);
#pragma unroll
        for (int nt = 0; nt < 4; ++nt) O[nt][j] *= fj;
      }
      mref = mnew;
    }
    float pv[8];
#pragma unroll
    for (int j = 0; j < 4; ++j) {
      pv[j] = __expf(sa[j] - mref);
      pv[4 + j] = __expf(sb[j] - mref);
      lsum += pv[j] + pv[4 + j];
    }
    bf16x8 pa;
#pragma unroll
    for (int j = 0; j < 8; ++j) pa[j] = (short)f2bf(pv[j]);
    const u16* vb;
    size_t tstride;
    if (kb < nloc) {
      vb = p.vtL + ((size_t)(b * 1024 + h * 64 + fr)) * SEQ + (y0 + kb) * 64 + c0 + fq * 4;
      tstride = SEQ;
    } else {
      vb = p.vtC + ((size_t)(b * 1024 + h * 64 + fr)) * CTX + (kb - nloc) * 32 + fq * 4;
      tstride = CTX;
    }
#pragma unroll
    for (int nt = 0; nt < 4; ++nt) {
      const u16* vp = vb + (size_t)(nt * 16) * tstride;
      uint2 lo = *(const uint2*)(vp);
      uint2 hi = *(const uint2*)(vp + 16);
      bf16x8 bv;
      bv[0] = (short)(lo.x & 0xffff); bv[1] = (short)(lo.x >> 16); bv[2] = (short)(lo.y & 0xffff); bv[3] = (short)(lo.y >> 16);
      bv[4] = (short)(hi.x & 0xffff); bv[5] = (short)(hi.x >> 16); bv[6] = (short)(hi.y & 0xffff); bv[7] = (short)(hi.y >> 16);
      O[nt] = __builtin_amdgcn_mfma_f32_16x16x32_bf16(pa, bv, O[nt], 0, 0, 0);
    }
  }
  lsum += __shfl_xor(lsum, 16);
  lsum += __shfl_xor(lsum, 32);
  float inv = 1.f / lsum;
  float invq[4];
#pragma unroll
  for (int j = 0; j < 4; ++j) invq[j] = __shfl(inv, fq * 4 + j);
#pragma unroll
  for (int j = 0; j < 4; ++j) {
    size_t row = qrow0 + fq * 4 + j;
    const u16* gp = P + row * EV_IN + 7424 + h * 64 + fr;
    u16* yp = p.y + row * 2048 + 1024 + h * 64 + fr;
#pragma unroll
    for (int nt = 0; nt < 4; ++nt) {
      float g = bf2f(gp[nt * 16]);
      yp[nt * 16] = f2bf(O[nt][j] * invq[j] * siluf_(g));
    }
  }
}

__device__ void natten_phase(int tid_, int bid_, int nblk_, const Params& p, int li) {
  const int w = __builtin_amdgcn_readfirstlane(tid_ >> 6);
  const int nbt = (16384 + 1024) / 4;
  for (int bt = bid_; bt < nbt; bt += nblk_) natten_tile(tid_, bid_, nblk_, p, li, bt * 4 + w);
}

__device__ void mix_phase(int tid_, int bid_, int nblk_, const Params& p, int li, char* smem) {
  if (nblk_ >= 512) {
    if (bid_ < 256) rwkv_scan_item(tid_, bid_, nblk_, p, li, bid_, smem);
  } else {
    for (int item = bid_; item < 256; item += nblk_) rwkv_scan_item(tid_, bid_, nblk_, p, li, item, smem);
  }
  const int w = __builtin_amdgcn_readfirstlane(tid_ >> 6);
  const int nbt = (16384 + 1024) / 4;
  int* slot = (int*)(smem + SMEM_BYTES - 16);
  int* head = p.cnt + li * 16;
  while (true) {
    __syncthreads();
    if (tid_ == 0) *slot = __hip_atomic_fetch_add(head, 1, __ATOMIC_RELAXED, __HIP_MEMORY_SCOPE_AGENT);
    __syncthreads();
    const int bt = *slot;
    if (bt < nbt) { natten_tile(tid_, bid_, nblk_, p, li, bt * 4 + w); continue; }
    if (li != 0) break;
    int j = bt - nbt;
    float* sm = (float*)smem;
    if (j < 264) { transpose_job64(tid_, j, 264, p.ev_w_in + (size_t)2048 * EV_IN, p.wt_ev_in + (size_t)2048 * EV_IN, 2048, EV_IN, 1, 0, 0, 2048, sm); continue; }
    j -= 264;
    if (j < 128) { transpose_job64(tid_, j, 128, p.ev_w_out, p.wt_ev_out, 2048, 2048, 2, (size_t)2048 * 2048, (size_t)2048 * 2048, 2048, sm); continue; }
    j -= 128;
    if (j < 320) { transpose_job64(tid_, j, 320, p.od_w_in, p.wt_od_in, 2048, OD_IN, 2, (size_t)2048 * OD_IN, (size_t)2048 * OD_IN, 2048, sm); continue; }
    j -= 320;
    if (j < 160) { transpose_job64(tid_, j, 160, p.od_w_out, p.wt_od_out, DC, 2048, 2, (size_t)DC * 2048, (size_t)DC * 2048, DC, sm); continue; }
    j -= 160;
    if (j < 100) { transpose_job(tid_, j, 100, p.od_ga_w, p.wt_gate, 160, 160, 64, 25600, 51200, 160, sm); continue; }
    j -= 100;
    if (j < 100) { transpose_job(tid_, j, 100, p.od_gx_w, p.wt_gate + 25600, 160, 160, 64, 25600, 51200, 160, sm); continue; }
    j -= 100;
    if (j < 288) { mod_phase(tid_, j, 288, p, smem, 96, 384); continue; }
    break;
  }
}

__device__ void readout_phase(int tid_, int bid_, int nblk_, const Params& p, int li) {
  const int lane = tid_ & 63, w = __builtin_amdgcn_readfirstlane(tid_ >> 6);
  const int gw = bid_ * 4 + w, nw = nblk_ * 4;
  const int h = lane >> 2, q = lane & 3;
  const int cbase = h * 64 + q * 16;
  const float* mu0 = p.ev_mu + (size_t)li * 2 * 3328 + 2048 + cbase;
  const float* mu1 = mu0 + 3328;
  for (int row = gw; row < MTOT; row += nw) {
    int t, T;
    if (row < MLAT) { t = row & 4095; T = SEQ; } else { t = (row - MLAT) & 255; T = CTX; }
    float o[16];
    const float* of = p.o_scan + (size_t)row * DA + cbase;
    const float* ob = p.o_scan + ((size_t)MTOT + row) * DA + cbase;
    float sum = 0.f;
#pragma unroll
    for (int i = 0; i < 4; ++i) {
      float4 a = *(const float4*)(of + i * 4);
      float4 c = *(const float4*)(ob + i * 4);
      o[i * 4 + 0] = a.x + c.x; o[i * 4 + 1] = a.y + c.y; o[i * 4 + 2] = a.z + c.z; o[i * 4 + 3] = a.w + c.w;
      sum += o[i * 4 + 0] + o[i * 4 + 1] + o[i * 4 + 2] + o[i * 4 + 3];
    }
    sum += __shfl_xor(sum, 1);
    sum += __shfl_xor(sum, 2);
    float mean = sum * (1.f / 64.f);
    float vs = 0.f;
#pragma unroll
    for (int i = 0; i < 16; ++i) { float d = o[i] - mean; vs += d * d; }
    vs += __shfl_xor(vs, 1);
    vs += __shfl_xor(vs, 2);
    float rstd = rsqrtf(vs * (1.f / 64.f) + 64e-5f);
    float rks = p.rk[(size_t)row * 16 + h] + p.rk[((size_t)MTOT + row) * 16 + h];
    const u16* pv = p.P + (size_t)row * EV_IN + 2048 + cbase;
    const u16* pg = p.P + (size_t)row * EV_IN + 3328 + cbase;
    u16* yp = p.y + (size_t)row * 2048 + cbase;
#pragma unroll
    for (int half = 0; half < 2; ++half) {
      uint4 cv = *(const uint4*)(pv + half * 8);
      uint4 pvv = (t > 0) ? *(const uint4*)(pv - EV_IN + half * 8) : make_uint4(0, 0, 0, 0);
      uint4 nv = (t < T - 1) ? *(const uint4*)(pv + EV_IN + half * 8) : make_uint4(0, 0, 0, 0);
      uint4 gv = *(const uint4*)(pg + half * 8);
      unsigned cw[4] = {cv.x, cv.y, cv.z, cv.w}, pw[4] = {pvv.x, pvv.y, pvv.z, pvv.w};
      unsigned nw4[4] = {nv.x, nv.y, nv.z, nv.w}, gw4[4] = {gv.x, gv.y, gv.z, gv.w};
      unsigned outw[4];
#pragma unroll
      for (int e = 0; e < 4; ++e) {
        float res[2];
#pragma unroll
        for (int hh = 0; hh < 2; ++hh) {
          int ci = half * 8 + e * 2 + hh;
          float c = hh ? bfhi(cw[e]) : bflo(cw[e]);
          float pp = hh ? bfhi(pw[e]) : bflo(pw[e]);
          float nn = hh ? bfhi(nw4[e]) : bflo(nw4[e]);
          float g = hh ? bfhi(gw4[e]) : bflo(gw4[e]);
          float vsh = c + mu0[ci] * (pp - c) + mu1[ci] * (nn - c);
          float on = (o[ci] - mean) * rstd * p.ev_gn_w[li * DA + cbase + ci] + p.ev_gn_b[li * DA + cbase + ci];
          res[hh] = (on + rks * vsh) * siluf_(g);
        }
        outw[e] = pack2(res[0], res[1]);
      }
      *(uint4*)(yp + half * 8) = make_uint4(outw[0], outw[1], outw[2], outw[3]);
    }
  }
}

__device__ void odd_tiles(int tid_, int bid_, int nblk_, const Params& p, int oi, int mode, bool skip_ctx, char* smem) {
  const int tid = tid_, lane = tid & 63, w = __builtin_amdgcn_readfirstlane(tid >> 6);
  const int fr = lane & 15, fq = lane >> 4;
  u16* sU = (u16*)smem;
  float* sA = (float*)(smem + 32 * 168 * 2);
  float* sB = sA + 32 * 160;
  float* sHf = sB + 32 * 160;
  const int ntiles = NB * NCH * 16;
  const int mt = w & 1, nh = w >> 1;
  uint2 xr[5][4];
#define ODD_DECODE(TILE)                                                              \
  const int blk = (TILE) & 15, cgl = ((TILE) >> 4) % NCH, b = ((TILE) >> 4) / NCH;    \
  int rowbase, T, t0;                                                                 \
  if (cgl < 8) { rowbase = MLAT + b * CTX; T = CTX; t0 = cgl * 32; }                  \
  else { rowbase = b * SEQ; T = SEQ; t0 = (cgl - 8) * 32; }                           \
  const int cb = blk * 160;
#define ODD_PREFETCH(TILE)                                                            \
  {                                                                                   \
    ODD_DECODE(TILE)                                                                  \
    _Pragma("unroll") for (int i = 0; i < 5; ++i) {                                   \
      int e = tid + i * 256, t = e / 40, c4 = (e % 40) * 4;                           \
      _Pragma("unroll") for (int j = 0; j < 4; ++j) {                                 \
        int tt = t0 + t - 2 + j;                                                      \
        xr[i][j] = (tt >= 0 && tt < T)                                                \
                       ? *(const uint2*)(p.P + (size_t)(rowbase + tt) * OD_IN + cb + c4) \
                       : make_uint2(0u, 0u);                                          \
      }                                                                               \
    }                                                                                 \
  }
  int tile = bid_;
  while (tile < ntiles && skip_ctx && ((tile >> 4) % NCH) < 8) tile += nblk_;
  if (tile < ntiles) ODD_PREFETCH(tile)
  while (tile < ntiles) {
    ODD_DECODE(tile)
#pragma unroll
    for (int i = 0; i < 5; ++i) {
      int e = tid + i * 256, t = e / 40, c4 = (e % 40) * 4;
      float4 acc = *(const float4*)(p.od_conv_b + oi * DC + cb + c4);
#pragma unroll
      for (int j = 0; j < 4; ++j) {
        uint2 xv = xr[i][j];
        float4 wv = *(const float4*)(p.od_conv_w + ((size_t)oi * 4 + j) * DC + cb + c4);
        acc.x += bflo(xv.x) * wv.x; acc.y += bfhi(xv.x) * wv.y; acc.z += bflo(xv.y) * wv.z; acc.w += bfhi(xv.y) * wv.w;
      }
      uint2 o;
      o.x = pack2(acc.x, acc.y);
      o.y = pack2(acc.z, acc.w);
      *(uint2*)(sU + t * 168 + c4) = o;
    }
    lds_barrier();
    int nxt = tile + nblk_;
    while (nxt < ntiles && skip_ctx && ((nxt >> 4) % NCH) < 8) nxt += nblk_;
    if (nxt < ntiles) ODD_PREFETCH(nxt)
    float cin0 = 0.f, cin1 = 0.f;
    uint2 gv[5];
    unsigned* abrow;
    {
      const int r0 = rowbase + t0;
      abrow = ((r0 < AB_R1) ? (p.abA + (size_t)r0 * DC) : (p.abB + (size_t)(r0 - AB_R1) * DC)) + cb;
    }
    if (mode == 1) {
      if (tid < 160) {
        const size_t sidx0 = ((size_t)((b * NCH + cgl) * 2 + 0)) * DC + cb + tid;
        cin0 = p.carry[sidx0];
        cin1 = p.carry[sidx0 + DC];
      }
#pragma unroll
      for (int i = 0; i < 5; ++i) {
        int e = tid + i * 256, t = e / 40, c4 = (e % 40) * 4;
        gv[i] = *(const uint2*)(p.P + (size_t)(rowbase + t0 + t) * OD_IN + DC + cb + c4);
      }
    }
    bf16x8 au[5];
#pragma unroll
    for (int ks = 0; ks < 5; ++ks) au[ks] = *(const bf16x8*)(sU + (mt * 16 + fr) * 168 + ks * 32 + fq * 8);
    for (int d = 0; d < 2; ++d) {
      const u16* Wg = p.wt_gate + ((size_t)((oi * 2 + d) * 16 + blk)) * 320 * 160;
      const float* gab = p.od_ga_b + (size_t)(oi * 2 + d) * DC + cb;
      const float* gxb = p.od_gx_b + (size_t)(oi * 2 + d) * DC + cb;
      const float* lam = p.od_lambda + (size_t)(oi * 2 + d) * DC + cb;
      float bavv[5], bxvv[5], splv[5];
#pragma unroll
      for (int q = 0; q < 5; ++q) {
        const int c = (nh * 5 + q) * 16 + fr;
        bavv[q] = gab[c];
        bxvv[q] = gxb[c];
        splv[q] = lam[c];
      }
      if (mode == 1 && d == 0) {
#pragma unroll
        for (int i = 0; i < 5; ++i) {
          int e = tid + i * 256, t = e / 40, c4 = (e % 40) * 4;
          const uint4 abq = *(const uint4*)(abrow + (size_t)t * DC + c4);
          unsigned wv[4] = {abq.x, abq.y, abq.z, abq.w};
          float av[4], bv4[4];
#pragma unroll
          for (int q = 0; q < 4; ++q) { av[q] = __expf(h2f_bits(wv[q])); bv4[q] = h2f_bits(wv[q] >> 16); }
          *(float4*)(sA + t * 160 + c4) = make_float4(av[0], av[1], av[2], av[3]);
          *(float4*)(sB + t * 160 + c4) = make_float4(bv4[0], bv4[1], bv4[2], bv4[3]);
        }
      } else {
      bf16x8 bA[5], bX[5];
      {
        const u16* wa = Wg + (size_t)(nh * 5 * 16 + fr) * 160 + fq * 8;
#pragma unroll
        for (int ks = 0; ks < 5; ++ks) {
          bA[ks] = *(const bf16x8*)(wa + ks * 32);
          bX[ks] = *(const bf16x8*)(wa + (size_t)160 * 160 + ks * 32);
        }
      }
#pragma unroll
      for (int nti = 0; nti < 5; ++nti) {
        const int nt = nh * 5 + nti;
        f32x4 accA = {0.f, 0.f, 0.f, 0.f}, accX = {0.f, 0.f, 0.f, 0.f};
#pragma unroll
        for (int ks = 0; ks < 5; ++ks) {
          accA = __builtin_amdgcn_mfma_f32_16x16x32_bf16(au[ks], bA[ks], accA, 0, 0, 0);
          accX = __builtin_amdgcn_mfma_f32_16x16x32_bf16(au[ks], bX[ks], accX, 0, 0, 0);
        }
        if (nti + 1 < 5) {
          const u16* wa = Wg + (size_t)((nt + 1) * 16 + fr) * 160 + fq * 8;
#pragma unroll
          for (int ks = 0; ks < 5; ++ks) {
            bA[ks] = *(const bf16x8*)(wa + ks * 32);
            bX[ks] = *(const bf16x8*)(wa + (size_t)160 * 160 + ks * 32);
          }
        }
        const int c = nt * 16 + fr;
        const float bav = bavv[nti], bxv = bxvv[nti];
        const float spl = softplusf_(-splv[nti]);
#pragma unroll
        for (int j = 0; j < 4; ++j) {
          int t = mt * 16 + fq * 4 + j;
          float gr = sigmoidf_(accA[j] + bav);
          float gi = sigmoidf_(accX[j] + bxv);
          float la = -8.f * gr * spl;
          float a = __expf(la);
          float uu = bf2f(sU[t * 168 + c]);
          float bb = __builtin_amdgcn_sqrtf(fmaxf(1.f - a * a, 0.f)) * gi * uu;
          if (d == 0) {
            const unsigned hl = f2h_bits(la), hb = f2h_bits(bb);
            a = __expf(h2f_bits(hl));
            bb = h2f_bits(hb);
            if (mode == 0) abrow[(size_t)t * DC + c] = hl | (hb << 16);
          }
          sA[t * 160 + c] = a;
          sB[t * 160 + c] = bb;
        }
      }
      }
      lds_barrier();
      if (tid < 160) {
        const int c = tid;
        const size_t sidx = ((size_t)((b * NCH + cgl) * 2 + d)) * DC + cb + c;
        if (mode == 0) {
          float hacc = 0.f, ap = 1.f;
#pragma unroll 4
          for (int s = 0; s < 32; ++s) {
            int t = d ? 31 - s : s;
            float a = sA[t * 160 + c];
            hacc = a * hacc + sB[t * 160 + c];
            ap *= a;
          }
          p.summ[sidx * 2] = ap;
          p.summ[sidx * 2 + 1] = hacc;
        } else {
          float hacc = d ? cin1 : cin0;
          float* dst = d ? sB : sHf;
#pragma unroll 4
          for (int s = 0; s < 32; ++s) {
            int t = d ? 31 - s : s;
            hacc = sA[t * 160 + c] * hacc + sB[t * 160 + c];
            dst[t * 160 + c] = hacc;
          }
        }
      }
      lds_barrier();
    }
    if (mode == 1) {
#pragma unroll
      for (int i = 0; i < 5; ++i) {
        int e = tid + i * 256, t = e / 40, c4 = (e % 40) * 4;
        size_t row = (size_t)(rowbase + t0 + t);
        float4 hf = *(const float4*)(sHf + t * 160 + c4);
        float4 hb = *(const float4*)(sB + t * 160 + c4);
        float y0 = (hf.x + hb.x) * siluf_(bflo(gv[i].x));
        float y1 = (hf.y + hb.y) * siluf_(bfhi(gv[i].x));
        float y2 = (hf.z + hb.z) * siluf_(bflo(gv[i].y));
        float y3 = (hf.w + hb.w) * siluf_(bfhi(gv[i].y));
        uint2 o;
        o.x = pack2(y0, y1);
        o.y = pack2(y2, y3);
        *(uint2*)(p.y + row * DC + cb + c4) = o;
      }
      lds_barrier();
    }
    tile = nxt;
  }
#undef ODD_DECODE
#undef ODD_PREFETCH
}

__device__ void odd_carry(int tid_, int bid_, int nblk_, const Params& p) {
  const int gt = bid_ * 256 + tid_;
  if (gt >= NB * 2 * DC) return;
  const int C = gt % DC, d = (gt / DC) & 1, b = gt / (2 * DC);
  float hcur = 0.f;
  for (int i = 0; i < NCH; ++i) {
    int cgl;
    if (d == 0) cgl = i;
    else cgl = (i < 8) ? (7 - i) : (NCH - 1 - (i - 8));
    size_t sidx = ((size_t)((b * NCH + cgl) * 2 + d)) * DC + C;
    p.carry[sidx] = hcur;
    hcur = p.summ[sidx * 2] * hcur + p.summ[sidx * 2 + 1];
  }
}

__device__ void run_phase(int tid_, int bid_, int nblk_, const Params& p, int ph, char* smem) {
#ifndef HALF_MASK
#define HALF_MASK 0
#endif
  {
    int type;
    if (ph == 0) type = 0;
    else if (ph == 1 || ph == 6 || ph == 12 || ph == 17 || ph == 23) type = 1;
    else if (ph == 2 || ph == 5 || ph == 7 || ph == 11 || ph == 13 || ph == 16 || ph == 18 || ph == 22) type = 2;
    else if (ph == 3 || ph == 14) type = 3;
    else if (ph == 4 || ph == 15) type = 4;
    else if (ph == 9 || ph == 20) type = 6;
    else type = 5;
    if ((HALF_MASK >> type) & 1) {
      if (bid_ >= 256) return;
      nblk_ = 256;
    }
  }
  if (ph == 0) {
    float* sm = (float*)smem;
    if (bid_ == 0 && tid_ < 64) p.cnt[tid_] = 0;
    transpose_job64(tid_, bid_, nblk_, p.ev_w_in, p.wt_ev_in, 2048, EV_IN, 1, (size_t)2048 * EV_IN, (size_t)2048 * EV_IN, 2048, sm);
    mod_phase(tid_, bid_, nblk_, p, smem, 0, 96);
    return;
  }
  if (ph == 1) { norm_phase(tid_, bid_, nblk_, p, -1, 0); return; }
  int L, s;
  if (ph <= 6) { L = 0; s = ph - 2; }
  else if (ph <= 12) { L = 1; s = ph - 7; }
  else if (ph <= 17) { L = 2; s = ph - 13; }
  else { L = 3; s = ph - 18; }
  const int i2 = L >> 1;
  if ((L & 1) == 0) {
    switch (s) {
      case 0:
        gemm_phase<1>(tid_, bid_, nblk_, p.h, D, p.wt_ev_in + (size_t)i2 * EV_IN * 2048, 2048, EV_IN, p.P, EV_IN, p.vtL, p.vtC, smem);
        break;
      case 1: mix_phase(tid_, bid_, nblk_, p, i2, smem); break;
      case 2: readout_phase(tid_, bid_, nblk_, p, i2); break;
      case 3:
        gemm_phase<2>(tid_, bid_, nblk_, p.y, 2048, p.wt_ev_out + (size_t)i2 * 2048 * 2048, 2048, 2048, p.z, 2048, nullptr, nullptr, smem);
        break;
      default: norm_phase(tid_, bid_, nblk_, p, L, L + 1); break;
    }
  } else {
    switch (s) {
      case 0:
        gemm_phase<0>(tid_, bid_, nblk_, p.h, D, p.wt_od_in + (size_t)i2 * OD_IN * 2048, 2048, OD_IN, p.P, OD_IN, nullptr, nullptr, smem);
        break;
      case 1: odd_tiles(tid_, bid_, nblk_, p, i2, 0, false, smem); break;
      case 2: odd_carry(tid_, bid_, nblk_, p); break;
      case 3: odd_tiles(tid_, bid_, nblk_, p, i2, 1, L == 3, smem); break;
      case 4:
        gemm_phase<2>(tid_, bid_, nblk_, p.y, DC, p.wt_od_out + (size_t)i2 * 2048 * DC, DC, 2048, p.z, 2048, nullptr, nullptr, smem,
                      (L == 3) ? MLAT / 128 : MTOT / 128);
        break;
      default: norm_phase(tid_, bid_, nblk_, p, L, L + 1); break;
    }
  }
}


#define XB_TMO      128
#define XB_XCNT(j)  (256  + 64 * (j))
#define XB_XSUB(j)  (1280 + 64 * (j))
#define XB_XGEN(j)  (2304 + 64 * (j))
#define XB_TOP      3328
#define XB_TOPGEN   3392
#define XCD_BAR_WORDS 3456
#define XB_SPIN_CAP (1u << 18)
#define LAS __attribute__((address_space(3)))

__device__ __forceinline__ unsigned xb_ld(unsigned* p) { return __hip_atomic_load(p, __ATOMIC_RELAXED, __HIP_MEMORY_SCOPE_AGENT); }
__device__ __forceinline__ unsigned xb_add(unsigned* p, unsigned v) { return __hip_atomic_fetch_add(p, v, __ATOMIC_RELAXED, __HIP_MEMORY_SCOPE_AGENT); }
__device__ __forceinline__ unsigned xb_xcc_id() { return (unsigned)__builtin_amdgcn_s_getreg((3 << 11) | 20) & 0xFu; }
#define XB_SPIN(cond, bar) do { unsigned _sp = 0; while (cond) { __builtin_amdgcn_s_sleep(1); \
    if ((++_sp & 255u) == 0u) { if (xb_ld(&(bar)[XB_TMO])) break; if (_sp > XB_SPIN_CAP) { atomicAdd(&(bar)[XB_TMO], 1u); break; } } } } while (0)

struct XcdBarrier {
  unsigned* bar; unsigned x;
  volatile LAS unsigned* st;
};

__device__ __forceinline__ XcdBarrier xcd_barrier_post(unsigned* bar, volatile LAS unsigned* st) {
  XcdBarrier b; b.bar = bar; b.x = xb_xcc_id(); b.st = st;
  if (threadIdx.x == 0) (void)xb_add(&bar[XB_XCNT(b.x)], 1u);
  return b;
}
__device__ __forceinline__ void xcd_barrier_complete(unsigned* bar, unsigned x, unsigned& nloc, unsigned& nx) {
  const unsigned G = gridDim.x * gridDim.y * gridDim.z;
  unsigned sum, cnt, mine, sp = 0u;
  for (;;) {
    sum = 0u; cnt = 0u; mine = 0u;
#pragma unroll
    for (unsigned j = 0; j < 16; ++j) { const unsigned c = xb_ld(&bar[XB_XCNT(j)]); sum += c; cnt += (c > 0u) ? 1u : 0u; mine = (j == x) ? c : mine; }
    if (sum == G) break;
    __builtin_amdgcn_s_sleep(1);
    if ((++sp & 255u) == 0u) { if (xb_ld(&bar[XB_TMO])) break; if (sp > XB_SPIN_CAP) { atomicAdd(&bar[XB_TMO], 1u); break; } }
  }
  nloc = mine > 0u ? mine : 1u; nx = cnt > 0u ? cnt : 1u;
}
__device__ __forceinline__ void xcd_barrier(const XcdBarrier& b) {
  asm volatile("s_waitcnt vmcnt(0)" ::: "memory");
  __syncthreads();
  if (threadIdx.x == 0) {
    unsigned* bar = b.bar;
    __builtin_amdgcn_s_waitcnt(0);
    unsigned nloc = b.st[0], nx = b.st[1];
    if (nloc == 0u) { xcd_barrier_complete(bar, b.x, nloc, nx); b.st[0] = nloc; b.st[1] = nx; }
    const unsigned old = xb_add(&bar[XB_XSUB(b.x)], 1u);
    const unsigned gen = old / nloc;
    if (old + 1u == (gen + 1u) * nloc) {
      __builtin_amdgcn_fence(__ATOMIC_RELEASE, "agent");
      asm volatile("s_waitcnt vmcnt(0)" ::: "memory");
      const unsigned og = xb_add(&bar[XB_TOP], 1u);
      const unsigned tg = og / nx;
      if (og + 1u == (tg + 1u) * nx) xb_add(&bar[XB_TOPGEN], 1u);
      else XB_SPIN(xb_ld(&bar[XB_TOPGEN]) == tg, bar);
      __builtin_amdgcn_fence(__ATOMIC_ACQUIRE, "agent");
      xb_add(&bar[XB_XGEN(b.x)], 1u);
      asm volatile("s_waitcnt vmcnt(0)" ::: "memory");
    } else {
      XB_SPIN(xb_ld(&bar[XB_XGEN(b.x)]) == gen, bar);
      __builtin_amdgcn_fence(__ATOMIC_ACQUIRE, "agent");
      asm volatile("s_waitcnt vmcnt(0)" ::: "memory");
    }
  }
  __syncthreads();
}

__global__ void __launch_bounds__(256, 2) fwd_megakernel(Params p) {
  __shared__ __attribute__((aligned(16))) char smem[SMEM_BYTES];
  cg::grid_group grid = cg::this_grid();
  volatile LAS unsigned* xst = (volatile LAS unsigned*)(smem + SMEM_BYTES - 32);
  if (threadIdx.x == 0) { xst[0] = 0u; xst[1] = 0u; }
  __syncthreads();
  const XcdBarrier xb = xcd_barrier_post(p.bar, xst);
  for (int ph = p.ph0; ph < p.ph1; ++ph) {
    int tid_ = threadIdx.x, bid_ = blockIdx.x, nblk_ = gridDim.x;
    asm volatile("" : "+v"(tid_), "+s"(bid_));
    run_phase(tid_, bid_, nblk_, p, ph, smem);
    if (ph + 1 < p.ph1) {
      if (p.ph0 < 0) grid.sync();
      xcd_barrier(xb);
    }
  }
}

extern "C" void kernel_launch(void* const* d_in, const int* in_sizes, int n_in, void* d_out, int out_size, void* d_ws,
                              size_t ws_size, hipStream_t stream) {
  static int grid_blocks = 0;
  if (!grid_blocks) {
    int dev = 0, cus = 0, per_cu = 0;
    hipGetDevice(&dev);
    hipDeviceGetAttribute(&cus, hipDeviceAttributeMultiprocessorCount, dev);
    hipOccupancyMaxActiveBlocksPerMultiprocessor(&per_cu, fwd_megakernel, 256, 0);
    if (per_cu > 2) per_cu = 2;
    if (per_cu < 1) per_cu = 1;
    grid_blocks = cus * per_cu;
  }
  Params p{};
  const float* const* in = (const float* const*)d_in;
  p.x = in[0]; p.c = in[1]; p.ctx = in[2]; p.c_ctx = in[3]; p.mod_w = in[4]; p.mod_b = in[5];
  p.norm_pre = in[6]; p.norm_post = in[7];
  p.ev_w_in = in[8]; p.ev_mu = in[9]; p.ev_w0 = in[10]; p.ev_w_up = in[11]; p.ev_a0 = in[12]; p.ev_a_up = in[13];
  p.ev_k_k = in[14]; p.ev_k_a = in[15]; p.ev_r_k = in[16]; p.ev_gn_w = in[17]; p.ev_gn_b = in[18]; p.ev_rpb = in[19];
  p.ev_w_out = in[20];
  p.od_w_in = in[21]; p.od_conv_w = in[22]; p.od_conv_b = in[23]; p.od_ga_w = in[24]; p.od_ga_b = in[25];
  p.od_gx_w = in[26]; p.od_gx_b = in[27]; p.od_lambda = in[28]; p.od_w_out = in[29];
  p.out = (float*)d_out;
  char* ws = (char*)d_ws;
  size_t off = 0;
  auto take = [&](size_t bytes) { char* r = ws + off; off += (bytes + 255) & ~(size_t)255; return r; };
  p.wt_ev_in = (u16*)take((size_t)2 * EV_IN * 2048 * 2);
  p.wt_ev_out = (u16*)take((size_t)2 * 2048 * 2048 * 2);
  p.wt_od_in = (u16*)take((size_t)2 * OD_IN * 2048 * 2);
  p.wt_od_out = (u16*)take((size_t)2 * 2048 * DC * 2);
  p.wt_gate = (u16*)take((size_t)64 * 320 * 160 * 2);
  p.mod = (float*)take((size_t)4 * 5 * 6144 * 4);
  p.xc = (float*)take((size_t)MCTX * D * 4);
  p.P = (u16*)take((size_t)MTOT * EV_IN * 2);
  p.z = (float*)p.P;
  p.y = (u16*)take((size_t)MTOT * DC * 2);
  p.vtL = (u16*)take((size_t)NB * 1024 * SEQ * 2);
  p.vtC = (u16*)take((size_t)NB * 1024 * CTX * 2);
  p.rk = (float*)take((size_t)2 * MTOT * 16 * 4);
  p.cnt = (int*)take(256);
  p.bar = (unsigned*)take((size_t)XCD_BAR_WORDS * 4);
  char* region = take((size_t)2 * MTOT * DA * 4);
  p.h = (u16*)region;
  p.o_scan = (float*)region;
  p.abA = (unsigned*)((char*)p.P + (size_t)MTOT * OD_IN * 2);
  p.abB = (unsigned*)region;
  p.summ = (float*)(region + (size_t)MTOT * D * 2);
  p.carry = p.summ + (size_t)NB * NCH * 2 * DC * 2;
  p.ph0 = 0;
  p.ph1 = 24;
  if (off > ws_size) {
    fprintf(stderr, "workspace too small: need %zu have %zu\n", off, ws_size);
    return;
  }
  (void)hipMemsetAsync(p.bar, 0, (size_t)XCD_BAR_WORDS * 4, stream);
  void* args[] = {&p};
  hipError_t e = hipLaunchCooperativeKernel((void*)fwd_megakernel, dim3(grid_blocks), dim3(256), args, 0, stream);
  if (e != hipSuccess) fprintf(stderr, "cooperative launch failed: %s (grid %d)\n", hipGetErrorString(e), grid_blocks);
}
```

```cpp
#include <hip/hip_runtime.h>
#include <hip/hip_bf16.h>
#include <hip/hip_cooperative_groups.h>
#include <cstdio>
namespace cg = cooperative_groups;

typedef unsigned short u16;
using bf16x8 = __attribute__((ext_vector_type(8))) short;
using f32x4 = __attribute__((ext_vector_type(4))) float;

constexpr int D = 2048, NB = 4, SEQ = 4096, CTX = 256;
constexpr int MLAT = NB * SEQ;
constexpr int MCTX = NB * CTX;
constexpr int MTOT = MLAT + MCTX;
constexpr int EV_IN = 8448, OD_IN = 5120, DC = 2560, DA = 1024;
constexpr int AB_R1 = 11264;
constexpr int NCH = 136;
#define HALF_MASK 0
constexpr int SMEM_BYTES = 72704;

struct Params {
  const float *x, *c, *ctx, *c_ctx, *mod_w, *mod_b, *norm_pre, *norm_post;
  const float *ev_w_in, *ev_mu, *ev_w0, *ev_w_up, *ev_a0, *ev_a_up, *ev_k_k, *ev_k_a, *ev_r_k, *ev_gn_w,
      *ev_gn_b, *ev_rpb, *ev_w_out;
  const float *od_w_in, *od_conv_w, *od_conv_b, *od_ga_w, *od_ga_b, *od_gx_w, *od_gx_b, *od_lambda, *od_w_out;
  float* out;
  u16 *wt_ev_in, *wt_ev_out, *wt_od_in, *wt_od_out, *wt_gate;
  float *mod, *xc;
  u16 *h, *P, *y, *vtL, *vtC;
  float *z, *o_scan, *rk, *summ, *carry;
  int* cnt;
  unsigned *abA, *abB;
  unsigned* bar;
  int ph0, ph1;
};

__device__ __forceinline__ u16 f2bf(float f) {
  unsigned u = __float_as_uint(f);
  u += 0x7fffu + ((u >> 16) & 1u);
  return (u16)(u >> 16);
}
__device__ __forceinline__ float bf2f(u16 h) { return __uint_as_float(((unsigned)h) << 16); }
__device__ __forceinline__ float bflo(unsigned v) { return __uint_as_float(v << 16); }
__device__ __forceinline__ float bfhi(unsigned v) { return __uint_as_float(v & 0xffff0000u); }
__device__ __forceinline__ unsigned pack2(float a, float b) { return (unsigned)f2bf(a) | ((unsigned)f2bf(b) << 16); }
__device__ __forceinline__ float sigmoidf_(float x) { return __builtin_amdgcn_rcpf(1.f + __expf(-x)); }
__device__ __forceinline__ float siluf_(float x) { return x * __builtin_amdgcn_rcpf(1.f + __expf(-x)); }
__device__ __forceinline__ float softplusf_(float x) { return fmaxf(x, 0.f) + __logf(1.f + __expf(-fabsf(x))); }
__device__ __forceinline__ float tanhf_(float x) { return 1.f - 2.f * __builtin_amdgcn_rcpf(1.f + __expf(2.f * x)); }

__device__ __forceinline__ unsigned f2h_bits(float x) { _Float16 h = (_Float16)x; return (unsigned)__builtin_bit_cast(unsigned short, h); }
__device__ __forceinline__ float h2f_bits(unsigned b) { return (float)__builtin_bit_cast(_Float16, (unsigned short)(b & 0xffffu)); }
template <int CTRL>
__device__ __forceinline__ float dpp_f(float v) {
  return __int_as_float(__builtin_amdgcn_update_dpp(0, __float_as_int(v), CTRL, 0xf, 0xf, true));
}
__device__ __forceinline__ float red8(float v) {
  v += dpp_f<0xB1>(v);
  v += dpp_f<0x4E>(v);
  v += dpp_f<0x141>(v);
  return v;
}
__device__ __forceinline__ float red16(float v) {
  v = red8(v);
  v += dpp_f<0x140>(v);
  return v;
}
__device__ __forceinline__ float wave_sum(float v) {
#pragma unroll
  for (int o = 32; o > 0; o >>= 1) v += __shfl_xor(v, o);
  return v;
}

__device__ __forceinline__ void lds_barrier() {
  asm volatile("s_waitcnt lgkmcnt(0)\n\ts_barrier" ::: "memory");
}

__device__ __forceinline__ int lds_byte(int r, int c) {
  int st = (r >> 4) * 2 + (c >> 5), rr = r & 15, cc = c & 31, ob = rr * 64 + cc * 2;
  return st * 1024 + (ob ^ (((ob >> 9) & 1) << 5));
}

__device__ void transpose_job(int tid_, int bid_, int nblk_, const float* __restrict__ src, u16* __restrict__ dst, int K, int N, int nbatch,
                              size_t sstride, size_t dstride, int ldd, float* sm) {
  const int tid = tid_;
  const int tk = K / 32, tn = N / 32, per = tk * tn, total = per * nbatch;
  for (int t = bid_; t < total; t += nblk_) {
    int bi = t / per, r = t % per, kt = r / tn, nt = r % tn;
    const float* s = src + (size_t)bi * sstride + (size_t)(kt * 32) * N + nt * 32;
#pragma unroll
    for (int i = 0; i < 4; ++i) {
      int kk = (tid >> 5) + 8 * i, nn = tid & 31;
      sm[kk * 33 + nn] = s[(size_t)kk * N + nn];
    }
    __syncthreads();
    {
      int n = tid >> 3, kc = tid & 7;
      float v0 = sm[(kc * 4 + 0) * 33 + n], v1 = sm[(kc * 4 + 1) * 33 + n];
      float v2 = sm[(kc * 4 + 2) * 33 + n], v3 = sm[(kc * 4 + 3) * 33 + n];
      uint2 o;
      o.x = pack2(v0, v1);
      o.y = pack2(v2, v3);
      *(uint2*)(dst + (size_t)bi * dstride + (size_t)(nt * 32 + n) * ldd + kt * 32 + kc * 4) = o;
    }
    __syncthreads();
  }
}

__device__ void transpose_job64(int tid_, int bid_, int nblk_, const float* __restrict__ src, u16* __restrict__ dst, int K, int N,
                                int nbatch, size_t sstride, size_t dstride, int ldd, float* sm) {
  const int tid = tid_;
  const int tk = K / 64, tn = N / 64, per = tk * tn, total = per * nbatch;
  for (int t = bid_; t < total; t += nblk_) {
    int bi = t / per, r = t % per, kt = r / tn, nt = r % tn;
    const float* s = src + (size_t)bi * sstride + (size_t)(kt * 64) * N + nt * 64;
#pragma unroll
    for (int i = 0; i < 16; ++i) {
      int kk = (tid >> 6) + 4 * i, nn = tid & 63;
      sm[kk * 65 + nn] = s[(size_t)kk * N + nn];
    }
    __syncthreads();
    {
      int n = tid >> 2, kc = tid & 3;
      unsigned o[8];
#pragma unroll
      for (int e = 0; e < 8; ++e) o[e] = pack2(sm[(kc * 16 + 2 * e) * 65 + n], sm[(kc * 16 + 2 * e + 1) * 65 + n]);
      u16* d = dst + (size_t)bi * dstride + (size_t)(nt * 64 + n) * ldd + kt * 64 + kc * 16;
      *(uint4*)(d) = make_uint4(o[0], o[1], o[2], o[3]);
      *(uint4*)(d + 8) = make_uint4(o[4], o[5], o[6], o[7]);
    }
    __syncthreads();
  }
}

__device__ void mod_phase(int tid_, int bid_, int nblk_, const Params& p, char* smem, int item0, int item1) {
  if (item0 + bid_ >= item1) return;
  float* sC = (float*)smem;
  float* sRed = sC + 5 * 2048;
  const int tid = tid_;
  for (int i = tid; i < 5 * 2048; i += 256) {
    int r = i / 2048, k = i % 2048;
    float v = (r < 4) ? p.c[r * 2048 + k] : p.c_ctx[k];
    sC[i] = siluf_(v);
  }
  __syncthreads();
  for (int item = item0 + bid_; item < item1; item += nblk_) {
    int layer = item / 96, col0 = (item % 96) * 64;
    const float* W = p.mod_w + (size_t)layer * 2048 * 6144;
    int kg = tid >> 4, cl = tid & 15, col = col0 + cl * 4;
    float acc[5][4];
#pragma unroll
    for (int r = 0; r < 5; ++r)
#pragma unroll
      for (int e = 0; e < 4; ++e) acc[r][e] = 0.f;
    for (int k = kg * 128; k < kg * 128 + 128; ++k) {
      float4 w4 = *(const float4*)(W + (size_t)k * 6144 + col);
#pragma unroll
      for (int r = 0; r < 5; ++r) {
        float s = sC[r * 2048 + k];
        acc[r][0] += s * w4.x; acc[r][1] += s * w4.y; acc[r][2] += s * w4.z; acc[r][3] += s * w4.w;
      }
    }
#pragma unroll
    for (int r = 0; r < 5; ++r)
#pragma unroll
      for (int e = 0; e < 4; ++e) sRed[(kg * 5 + r) * 64 + cl * 4 + e] = acc[r][e];
    __syncthreads();
    for (int o = tid; o < 320; o += 256) {
      int r = o / 64, cc = o % 64;
      float s = 0.f;
#pragma unroll
      for (int g = 0; g < 16; ++g) s += sRed[(g * 5 + r) * 64 + cc];
      p.mod[(layer * 5 + r) * 6144 + col0 + cc] = s + p.mod_b[layer * 6144 + col0 + cc];
    }
    __syncthreads();
  }
}

__device__ void norm_phase(int tid_, int bid_, int nblk_, const Params& p, int lprev, int lnext) {
  const int lane = tid_ & 63, w = __builtin_amdgcn_readfirstlane(tid_ >> 6);
  const int gw = bid_ * 4 + w, nw = nblk_ * 4;
  for (int row = gw; row < MTOT; row += nw) {
    const bool isctx = row >= MLAT;
    if (isctx && lprev == 3) continue;
    const int mrow = isctx ? 4 : row / SEQ;
    const float* xold;
    float* xnew;
    if (!isctx) {
      xold = (lprev <= 0 ? p.x : p.out) + (size_t)row * D;
      xnew = p.out + (size_t)row * D;
    } else {
      int cr = row - MLAT;
      xold = (lprev <= 0 ? p.ctx : p.xc) + (size_t)cr * D;
      xnew = p.xc + (size_t)cr * D;
    }
    float xv[32];
#pragma unroll
    for (int i = 0; i < 8; ++i) {
      float4 v = *(const float4*)(xold + i * 256 + lane * 4);
      xv[i * 4 + 0] = v.x; xv[i * 4 + 1] = v.y; xv[i * 4 + 2] = v.z; xv[i * 4 + 3] = v.w;
    }
    if (lprev >= 0) {
      const float* zr = p.z + (size_t)row * D;
      float zv[32];
      float ss = 0.f;
#pragma unroll
      for (int i = 0; i < 8; ++i) {
        float4 v = *(const float4*)(zr + i * 256 + lane * 4);
        zv[i * 4 + 0] = v.x; zv[i * 4 + 1] = v.y; zv[i * 4 + 2] = v.z; zv[i * 4 + 3] = v.w;
        ss += v.x * v.x + v.y * v.y + v.z * v.z + v.w * v.w;
      }
      ss = wave_sum(ss);
      float rs = rsqrtf(ss * (1.f / 2048.f) + 1e-6f);
      const float* gate = p.mod + (lprev * 5 + mrow) * 6144 + 4096;
      const float* np = p.norm_post + lprev * D;
#pragma unroll
      for (int i = 0; i < 8; ++i) {
        int idx = i * 256 + lane * 4;
        float4 g4 = *(const float4*)(gate + idx);
        float4 n4 = *(const float4*)(np + idx);
        xv[i * 4 + 0] += g4.x * (zv[i * 4 + 0] * rs * n4.x);
        xv[i * 4 + 1] += g4.y * (zv[i * 4 + 1] * rs * n4.y);
        xv[i * 4 + 2] += g4.z * (zv[i * 4 + 2] * rs * n4.z);
        xv[i * 4 + 3] += g4.w * (zv[i * 4 + 3] * rs * n4.w);
        float4 o;
        o.x = xv[i * 4 + 0]; o.y = xv[i * 4 + 1]; o.z = xv[i * 4 + 2]; o.w = xv[i * 4 + 3];
        *(float4*)(xnew + idx) = o;
      }
    }
    if (lnext <= 3) {
      float ss = 0.f;
#pragma unroll
      for (int i = 0; i < 32; ++i) ss += xv[i] * xv[i];
      ss = wave_sum(ss);
      float rs = rsqrtf(ss * (1.f / 2048.f) + 1e-6f);
      const float* shift = p.mod + (lnext * 5 + mrow) * 6144;
      const float* scale = shift + 2048;
      const float* npre = p.norm_pre + lnext * D;
      u16* hr = p.h + (size_t)row * D;
#pragma unroll
      for (int i = 0; i < 8; ++i) {
        int idx = i * 256 + lane * 4;
        float4 s4 = *(const float4*)(shift + idx);
        float4 c4 = *(const float4*)(scale + idx);
        float4 n4 = *(const float4*)(npre + idx);
        float h0 = xv[i * 4 + 0] * rs * n4.x * (1.f + c4.x) + s4.x;
        float h1 = xv[i * 4 + 1] * rs * n4.y * (1.f + c4.y) + s4.y;
        float h2 = xv[i * 4 + 2] * rs * n4.z * (1.f + c4.z) + s4.z;
        float h3 = xv[i * 4 + 3] * rs * n4.w * (1.f + c4.w) + s4.w;
        uint2 o;
        o.x = pack2(h0, h1);
        o.y = pack2(h2, h3);
        *(uint2*)(hr + idx) = o;
      }
    }
  }
}

template <int MODE>
__device__ void gemm_phase(int tid_, int bid_, int nblk_, const u16* __restrict__ A, int lda, const u16* __restrict__ Bt, int K, int N, void* Cout,
                           int ldc, u16* vtL, u16* vtC, char* smem, int MT = MTOT / 128) {
  const int tid = tid_, lane = tid & 63, wid = __builtin_amdgcn_readfirstlane(tid >> 6);
  const int wm = wid >> 1, wn = wid & 1, fr = lane & 15, fq = lane >> 4;
  const int NT = N / 128, ntiles = MT * NT, nk = K / 64;
  const int GM = 8, nig = GM * NT;
  const int pr = tid >> 3, pc8 = tid & 7;
  const int bpx = nblk_ >> 3;
  for (int it = 0; (it * 8) * bpx < ntiles; ++it) {
    const int tile = (it * 8 + (bid_ & 7)) * bpx + (bid_ >> 3);
    if (tile >= ntiles) continue;
    int gid = tile / nig, fm = gid * GM;
    int pm = fm + (tile % nig) % GM, pn = (tile % nig) / GM;
    const int row0 = pm * 128, col0 = pn * 128;
    const u16* gA = A + (size_t)(row0 + pr) * lda + pc8 * 8;
    const u16* gB = Bt + (size_t)(col0 + pr) * K + pc8 * 8;
    f32x4 acc[4][4];
#pragma unroll
    for (int i = 0; i < 4; ++i)
#pragma unroll
      for (int j = 0; j < 4; ++j) acc[i][j] = f32x4{0.f, 0.f, 0.f, 0.f};
    const u16* srcA[4];
    const u16* srcB[4];
#pragma unroll
    for (int i = 0; i < 4; ++i) {
      int bb = tid * 16 + i * 4096;
      int st = bb >> 10, sb = bb & 1023, swz = sb ^ (((sb >> 9) & 1) << 5);
      int R = (st >> 1) * 16 + (swz >> 6), Cc = (st & 1) * 32 + ((swz & 63) >> 1);
      srcA[i] = A + (size_t)(row0 + R) * lda + Cc;
      srcB[i] = Bt + (size_t)(col0 + R) * K + Cc;
    }
    auto stage = [&](int kt, int BUF) {
#pragma unroll
      for (int i = 0; i < 4; ++i) {
        char* la = smem + BUF * 32768 + tid * 16 + i * 4096;
        __builtin_amdgcn_global_load_lds((const unsigned*)(srcA[i] + kt * 64),
                                         (__attribute__((address_space(3))) unsigned*)la, 16, 0, 0);
        __builtin_amdgcn_global_load_lds((const unsigned*)(srcB[i] + kt * 64),
                                         (__attribute__((address_space(3))) unsigned*)(la + 16384), 16, 0, 0);
      }
    };
    auto compute = [&](int BUF) {
      const char* sa = smem + BUF * 32768;
      const char* sb = sa + 16384;
      bf16x8 af[4][2], bfr[4][2];
#pragma unroll
      for (int ms = 0; ms < 4; ++ms)
#pragma unroll
        for (int ks = 0; ks < 2; ++ks)
          af[ms][ks] = *(const bf16x8*)(sa + lds_byte(wm * 64 + ms * 16 + fr, ks * 32 + fq * 8));
#pragma unroll
      for (int ns = 0; ns < 4; ++ns)
#pragma unroll
        for (int ks = 0; ks < 2; ++ks)
          bfr[ns][ks] = *(const bf16x8*)(sb + lds_byte(wn * 64 + ns * 16 + fr, ks * 32 + fq * 8));
      __builtin_amdgcn_s_setprio(1);
#pragma unroll
      for (int ks = 0; ks < 2; ++ks)
#pragma unroll
        for (int ms = 0; ms < 4; ++ms)
#pragma unroll
          for (int ns = 0; ns < 4; ++ns)
            acc[ms][ns] = __builtin_amdgcn_mfma_f32_16x16x32_bf16(bfr[ns][ks], af[ms][ks], acc[ms][ns], 0, 0, 0);
      __builtin_amdgcn_s_setprio(0);
    };
    stage(0, 0);
    asm volatile("s_waitcnt vmcnt(0)" ::: "memory");
    lds_barrier();
    for (int kt = 0; kt < nk; ++kt) {
      if (kt + 1 < nk) stage(kt + 1, (kt + 1) & 1);
      compute(kt & 1);
      asm volatile("s_waitcnt vmcnt(0)" ::: "memory");
      lds_barrier();
    }
    const bool vt = (MODE == 1) && (col0 >= 6400) && (col0 < 7424);
#pragma unroll
    for (int ms = 0; ms < 4; ++ms) {
      const int m = row0 + wm * 64 + ms * 16 + fr;
#pragma unroll
      for (int ns = 0; ns < 4; ++ns) {
        const int n = col0 + wn * 64 + ns * 16 + fq * 4;
        f32x4 v = acc[ms][ns];
        if (MODE == 2) {
          float4 o;
          o.x = v[0]; o.y = v[1]; o.z = v[2]; o.w = v[3];
          *(float4*)((float*)Cout + (size_t)m * ldc + n) = o;
        } else if (vt) {
          int cn = n - 6400;
          if (m < MLAT) {
            int b = m >> 12, t = m & 4095;
#pragma unroll
            for (int j = 0; j < 4; ++j) vtL[((size_t)(b * 1024 + cn + j)) * SEQ + t] = f2bf(v[j]);
          } else {
            int b = (m - MLAT) >> 8, t = (m - MLAT) & 255;
#pragma unroll
            for (int j = 0; j < 4; ++j) vtC[((size_t)(b * 1024 + cn + j)) * CTX + t] = f2bf(v[j]);
          }
        } else {
          uint2 o;
          o.x = pack2(v[0], v[1]);
          o.y = pack2(v[2], v[3]);
          *(uint2*)((u16*)Cout + (size_t)m * ldc + n) = o;
        }
      }
    }
  }
}

struct Pre {
  uint2 cur[5], prv[5], nxt[5];
};

__device__ __forceinline__ void chunk_info(int gc, int b, int dir, int& rowbase, int& T, int& tb) {
  int c;
  if (gc < 16) { rowbase = MLAT + b * CTX; T = CTX; c = gc; }
  else { rowbase = b * SEQ; T = SEQ; c = gc - 16; }
  tb = dir ? (T - 16 - c * 16) : (c * 16);
}

typedef float v2f __attribute__((ext_vector_type(2)));

typedef float v2f __attribute__((ext_vector_type(2)));

__device__ void rwkv_scan_item(int tid_, int bid_, int nblk_, const Params& p, int li, int item, char* smem) {
  const int half = item & 1, dir = (item >> 1) & 1, h = (item >> 2) & 15, b = item >> 6;
  const int tid = tid_, lane = tid & 63, w = __builtin_amdgcn_readfirstlane(tid >> 6);
  const int fr = lane & 15, fq = lane >> 4;
  float* sW = (float*)smem;
  float* sKK = sW + 1024;
  float* sKKA = sKK + 1024;
  float* sKD = sKKA + 1024;
  float* sR = sKD + 1024;
  float* sV = sR + 1024;
  float* sK = sV + 1024;
  float* sO = sK + 1024;
  u16* sAw = (u16*)(sO + 1024);
  u16* sAa = sAw + 16 * 72;
  float* sMu0 = (float*)(sAa + 16 * 72);
  float* sMu1 = sMu0 + 320;
  float* sKk = sMu1 + 320;
  float* sRk = sKk + 64;
  const u16* P = p.P;
  const int sA_s0 = tid >> 4, sA_cc0 = tid & 15;
  int goff[5];
  goff[0] = h * 64; goff[1] = 1024 + h * 64; goff[2] = 2048 + h * 64; goff[3] = 3072 + dir * 64; goff[4] = 3200 + dir * 64;
  __syncthreads();
  {
    const float* mu0 = p.ev_mu + (size_t)li * 2 * 3328;
    const float* mu1 = mu0 + 3328;
    for (int i = tid; i < 320; i += 256) {
      int g = i >> 6, c = i & 63;
      sMu0[i] = mu0[goff[g] + c];
      sMu1[i] = mu1[goff[g] + c];
    }
    if (tid < 64) {
      sKk[tid] = p.ev_k_k[li * DA + h * 64 + tid];
      sRk[tid] = p.ev_r_k[(li * 16 + h) * 64 + tid];
    }
  }
  const int keyB = 16 * w + fr;
  const float w0v = p.ev_w0[(li * 2 + dir) * DA + h * 64 + keyB];
  const float a0v = p.ev_a0[(li * 2 + dir) * DA + h * 64 + keyB];
  const float kav = p.ev_k_a[li * DA + h * 64 + keyB];
  bf16x8 bw[2], ba[2];
  {
    const float* wu = p.ev_w_up + (size_t)(li * 2 + dir) * 64 * DA + h * 64 + keyB;
    const float* au = p.ev_a_up + (size_t)(li * 2 + dir) * 64 * DA + h * 64 + keyB;
#pragma unroll
    for (int ks = 0; ks < 2; ++ks)
#pragma unroll
      for (int j = 0; j < 8; ++j) {
        int k = ks * 32 + fq * 8 + j;
        bw[ks][j] = (short)f2bf(wu[(size_t)k * DA]);
        ba[ks][j] = (short)f2bf(au[(size_t)k * DA]);
      }
  }
  const int rlC = 8 * w + (lane >> 3), ksC = lane & 7;
  const int vrowC = half * 32 + rlC;
  v2f S[4];
#pragma unroll
  for (int k = 0; k < 4; ++k) S[k] = v2f{0.f, 0.f};

  auto load_pre = [&](int gc, Pre& pre, int sA_s, int sA_cc) {
    int rowbase, T, tb;
    chunk_info(gc, b, dir, rowbase, T, tb);
    int t = dir ? (tb + 15 - sA_s) : (tb + sA_s);
    const u16* base = P + (size_t)(rowbase + t) * EV_IN + sA_cc * 4;
#pragma unroll
    for (int g = 0; g < 5; ++g) {
      pre.cur[g] = *(const uint2*)(base + goff[g]);
      pre.prv[g] = (t > 0) ? *(const uint2*)(base - EV_IN + goff[g]) : make_uint2(0u, 0u);
      pre.nxt[g] = (t < T - 1) ? *(const uint2*)(base + EV_IN + goff[g]) : make_uint2(0u, 0u);
    }
  };

  Pre pre;
  load_pre(0, pre, sA_s0, sA_cc0);
  __syncthreads();
  const int NGC = 16 + 256;
  for (int gc = 0; gc <= NGC; ++gc) {
    int sA_s = sA_s0, sA_cc = sA_cc0;
    asm volatile("" : "+v"(sA_s), "+v"(sA_cc));
    if (gc > 0) {
      int rowbase, T, tb;
      chunk_info(gc - 1, b, dir, rowbase, T, tb);
      if (tid < 128) {
        int s = tid >> 3, c4 = (tid & 7) * 4;
        int t = dir ? (tb + 15 - s) : (tb + s);
        float4 o4 = *(const float4*)(sO + s * 32 + c4);
        *(float4*)(p.o_scan + ((size_t)dir * MTOT + rowbase + t) * DA + h * 64 + half * 32 + c4) = o4;
      }
      if (half == ((gc - 1) & 1)) {
        int t = dir ? (tb + 15 - sA_s) : (tb + sA_s);
        size_t row = (size_t)(rowbase + t);
        float4 r4 = *(const float4*)(sR + sA_s * 64 + sA_cc * 4);
        float4 k4 = *(const float4*)(sKD + sA_s * 64 + sA_cc * 4);
        float4 q4 = *(const float4*)(sRk + sA_cc * 4);
        float s = r4.x * k4.x * q4.x + r4.y * k4.y * q4.y + r4.z * k4.z * q4.z + r4.w * k4.w * q4.w;
        s = red16(s);
        if (sA_cc == 0) p.rk[((size_t)dir * MTOT + row) * 16 + h] = s;
      }
    }
    if (gc == NGC) break;
    {
      float val[5][4];
#pragma unroll
      for (int g = 0; g < 5; ++g) {
        float4 m0 = *(const float4*)(sMu0 + g * 64 + sA_cc * 4);
        float4 m1 = *(const float4*)(sMu1 + g * 64 + sA_cc * 4);
        float c0 = bflo(pre.cur[g].x), c1 = bfhi(pre.cur[g].x), c2 = bflo(pre.cur[g].y), c3 = bfhi(pre.cur[g].y);
        float p0 = bflo(pre.prv[g].x), p1 = bfhi(pre.prv[g].x), p2 = bflo(pre.prv[g].y), p3 = bfhi(pre.prv[g].y);
        float n0 = bflo(pre.nxt[g].x), n1 = bfhi(pre.nxt[g].x), n2 = bflo(pre.nxt[g].y), n3 = bfhi(pre.nxt[g].y);
        val[g][0] = c0 + m0.x * (p0 - c0) + m1.x * (n0 - c0);
        val[g][1] = c1 + m0.y * (p1 - c1) + m1.y * (n1 - c1);
        val[g][2] = c2 + m0.z * (p2 - c2) + m1.z * (n2 - c2);
        val[g][3] = c3 + m0.w * (p3 - c3) + m1.w * (n3 - c3);
      }
      const int so = sA_s * 64 + sA_cc * 4;
      *(float4*)(sR + so) = make_float4(val[0][0], val[0][1], val[0][2], val[0][3]);
      *(float4*)(sK + so) = make_float4(val[1][0], val[1][1], val[1][2], val[1][3]);
      *(float4*)(sV + so) = make_float4(val[2][0], val[2][1], val[2][2], val[2][3]);
      float4 kk4 = *(const float4*)(sKk + sA_cc * 4);
      float q0 = val[1][0] * kk4.x, q1 = val[1][1] * kk4.y, q2 = val[1][2] * kk4.z, q3 = val[1][3] * kk4.w;
      float ss = red16(q0 * q0 + q1 * q1 + q2 * q2 + q3 * q3);
      float rn = rsqrtf(ss + 1e-12f);
      *(float4*)(sKK + so) = make_float4(q0 * rn, q1 * rn, q2 * rn, q3 * rn);
      uint2 tw, ta;
      tw.x = pack2(tanhf_(val[3][0]), tanhf_(val[3][1]));
      tw.y = pack2(tanhf_(val[3][2]), tanhf_(val[3][3]));
      ta.x = pack2(val[4][0], val[4][1]);
      ta.y = pack2(val[4][2], val[4][3]);
      *(uint2*)(sAw + sA_s * 72 + sA_cc * 4) = tw;
      *(uint2*)(sAa + sA_s * 72 + sA_cc * 4) = ta;
    }
    lds_barrier();
    if (gc + 1 < NGC) load_pre(gc + 1, pre, sA_s, sA_cc);
    {
      f32x4 dw = {0.f, 0.f, 0.f, 0.f}, da = {0.f, 0.f, 0.f, 0.f};
#pragma unroll
      for (int ks = 0; ks < 2; ++ks) {
        bf16x8 aw = *(const bf16x8*)(sAw + fr * 72 + ks * 32 + fq * 8);
        bf16x8 aa = *(const bf16x8*)(sAa + fr * 72 + ks * 32 + fq * 8);
        dw = __builtin_amdgcn_mfma_f32_16x16x32_bf16(aw, bw[ks], dw, 0, 0, 0);
        da = __builtin_amdgcn_mfma_f32_16x16x32_bf16(aa, ba[ks], da, 0, 0, 0);
      }
#pragma unroll
      for (int j = 0; j < 4; ++j) {
        int s = fq * 4 + j;
        float xw = dw[j] + w0v;
        float dec = __expf(-0.60653066f * sigmoidf_(xw));
        float a = sigmoidf_(a0v + da[j]);
        float kx = sK[s * 64 + keyB], kkx = sKK[s * 64 + keyB];
        sW[s * 64 + keyB] = dec;
        sKD[s * 64 + keyB] = kx * (1.f + (a - 1.f) * kav);
        sKKA[s * 64 + keyB] = kkx * a;
      }
    }
    lds_barrier();
    {
      float4 cur[10], nxt[10];
      float vcur, vnxt;
      {
        const int o8 = ksC * 8;
        cur[0] = *(const float4*)(sKK + o8); cur[1] = *(const float4*)(sKK + o8 + 4);
        cur[2] = *(const float4*)(sW + o8); cur[3] = *(const float4*)(sW + o8 + 4);
        cur[4] = *(const float4*)(sKKA + o8); cur[5] = *(const float4*)(sKKA + o8 + 4);
        cur[6] = *(const float4*)(sKD + o8); cur[7] = *(const float4*)(sKD + o8 + 4);
        cur[8] = *(const float4*)(sR + o8); cur[9] = *(const float4*)(sR + o8 + 4);
        vcur = sV[vrowC];
      }
#pragma unroll
      for (int s = 0; s < 16; ++s) {
        if (s + 1 < 16) {
          const int o8 = (s + 1) * 64 + ksC * 8;
          nxt[0] = *(const float4*)(sKK + o8); nxt[1] = *(const float4*)(sKK + o8 + 4);
          nxt[2] = *(const float4*)(sW + o8); nxt[3] = *(const float4*)(sW + o8 + 4);
          nxt[4] = *(const float4*)(sKKA + o8); nxt[5] = *(const float4*)(sKKA + o8 + 4);
          nxt[6] = *(const float4*)(sKD + o8); nxt[7] = *(const float4*)(sKD + o8 + 4);
          nxt[8] = *(const float4*)(sR + o8); nxt[9] = *(const float4*)(sR + o8 + 4);
          vnxt = sV[(s + 1) * 64 + vrowC];
        }
        v2f kk[4] = {v2f{cur[0].x, cur[0].y}, v2f{cur[0].z, cur[0].w}, v2f{cur[1].x, cur[1].y}, v2f{cur[1].z, cur[1].w}};
        v2f ww[4] = {v2f{cur[2].x, cur[2].y}, v2f{cur[2].z, cur[2].w}, v2f{cur[3].x, cur[3].y}, v2f{cur[3].z, cur[3].w}};
        v2f ka[4] = {v2f{cur[4].x, cur[4].y}, v2f{cur[4].z, cur[4].w}, v2f{cur[5].x, cur[5].y}, v2f{cur[5].z, cur[5].w}};
        v2f kd[4] = {v2f{cur[6].x, cur[6].y}, v2f{cur[6].z, cur[6].w}, v2f{cur[7].x, cur[7].y}, v2f{cur[7].z, cur[7].w}};
        v2f rr[4] = {v2f{cur[8].x, cur[8].y}, v2f{cur[8].z, cur[8].w}, v2f{cur[9].x, cur[9].y}, v2f{cur[9].z, cur[9].w}};
        v2f a0 = S[0] * kk[0], a1 = S[1] * kk[1];
        a0 = __builtin_elementwise_fma(S[2], kk[2], a0);
        a1 = __builtin_elementwise_fma(S[3], kk[3], a1);
        a0 += a1;
        const float sa = red8(a0.x + a0.y);
        const v2f nsa = v2f{-sa, -sa}, vv = v2f{vcur, vcur};
#pragma unroll
        for (int k = 0; k < 4; ++k) {
          v2f t = S[k] * ww[k];
          t = __builtin_elementwise_fma(vv, kd[k], t);
          S[k] = __builtin_elementwise_fma(nsa, ka[k], t);
        }
        v2f o0 = S[0] * rr[0], o1 = S[1] * rr[1];
        o0 = __builtin_elementwise_fma(S[2], rr[2], o0);
        o1 = __builtin_elementwise_fma(S[3], rr[3], o1);
        o0 += o1;
        const float ov = red8(o0.x + o0.y);
        sO[s * 32 + rlC] = ov;
        if (s + 1 < 16) {
#pragma unroll
          for (int q = 0; q < 10; ++q) cur[q] = nxt[q];
          vcur = vnxt;
        }
      }
    }
    lds_barrier();
  }
}

__device__ void natten_tile(int tid_, int bid_, int nblk_, const Params& p, int li, int wt) {
  const int lane = tid_ & 63, fr = lane & 15, fq = lane >> 4;
  const u16* P = p.P;
  int b, h, y = 0, x0 = 0, nloc;
  size_t qrow0;
  if (wt < 16384) {
    int xg = wt & 3; y = (wt >> 2) & 63; h = (wt >> 8) & 15; b = wt >> 12;
    x0 = xg * 16; nloc = 8;
    qrow0 = (size_t)b * SEQ + y * 64 + x0;
  } else {
    int t2 = wt - 16384;
    int qg = t2 & 15; h = (t2 >> 4) & 15; b = t2 >> 8;
    nloc = 0;
    qrow0 = (size_t)MLAT + b * CTX + qg * 16;
  }
  const int y0 = min(max(y - 4, 0), 56);
  const int c0 = (x0 == 0) ? 0 : (x0 == 16 ? 8 : (x0 == 32 ? 24 : 32));
  const int xq = x0 + fr;
  const int cs = min(max(xq - 8, 0), 48);
  const float* rpb = p.ev_rpb + (size_t)(li * 16 + h) * 15 * 31;
  bf16x8 bq[2];
  {
    const u16* qp = P + (qrow0 + fr) * EV_IN + 4352 + h * 64 + fq * 8;
    bq[0] = *(const bf16x8*)(qp);
    bq[1] = *(const bf16x8*)(qp + 32);
  }
  const int nblk = nloc + 8;
  auto key_base = [&](int kb) -> size_t {
    return (kb < nloc) ? ((size_t)b * SEQ + (y0 + kb) * 64 + c0) : ((size_t)MLAT + b * CTX + (kb - nloc) * 32);
  };
  auto scores = [&](int kb, f32x4& sa, f32x4& sb) {
    size_t kr = key_base(kb);
    const u16* kp = P + (kr + fr) * EV_IN + 5376 + h * 64 + fq * 8;
    bf16x8 a0 = *(const bf16x8*)(kp);
    bf16x8 a1 = *(const bf16x8*)(kp + 32);
    bf16x8 a2 = *(const bf16x8*)(kp + (size_t)16 * EV_IN);
    bf16x8 a3 = *(const bf16x8*)(kp + (size_t)16 * EV_IN + 32);
    sa = f32x4{0.f, 0.f, 0.f, 0.f};
    sb = f32x4{0.f, 0.f, 0.f, 0.f};
    sa = __builtin_amdgcn_mfma_f32_16x16x32_bf16(a0, bq[0], sa, 0, 0, 0);
    sa = __builtin_amdgcn_mfma_f32_16x16x32_bf16(a1, bq[1], sa, 0, 0, 0);
    sb = __builtin_amdgcn_mfma_f32_16x16x32_bf16(a2, bq[0], sb, 0, 0, 0);
    sb = __builtin_amdgcn_mfma_f32_16x16x32_bf16(a3, bq[1], sb, 0, 0, 0);
    if (kb < nloc) {
      const float* rb = rpb + (y0 + kb - y + 7) * 31;
#pragma unroll
      for (int j = 0; j < 4; ++j) {
        int kc = c0 + fq * 4 + j;
        int kc2 = kc + 16;
        bool v1 = (kc >= cs) && (kc < cs + 16);
        bool v2 = (kc2 >= cs) && (kc2 < cs + 16);
        float b1 = v1 ? rb[kc - xq + 15] : 0.f;
        float b2 = v2 ? rb[kc2 - xq + 15] : 0.f;
        sa[j] = v1 ? sa[j] * 0.125f + b1 : -1e30f;
        sb[j] = v2 ? sb[j] * 0.125f + b2 : -1e30f;
      }
    } else {
#pragma unroll
      for (int j = 0; j < 4; ++j) { sa[j] *= 0.125f; sb[j] *= 0.125f; }
    }
  };
  const float THR = 0.f;
  float mref = -1e30f;
  f32x4 O[4];
#pragma unroll
  for (int nt = 0; nt < 4; ++nt) O[nt] = f32x4{0.f, 0.f, 0.f, 0.f};
  float lsum = 0.f;
#pragma unroll 2
  for (int kb = 0; kb < nblk; ++kb) {
    f32x4 sa, sb;
    scores(kb, sa, sb);
    float bm = fmaxf(fmaxf(fmaxf(sa[0], sa[1]), fmaxf(sa[2], sa[3])), fmaxf(fmaxf(sb[0], sb[1]), fmaxf(sb[2], sb[3])));
    if (__any(bm > mref + THR)) {
      bm = fmaxf(bm, __shfl_xor(bm, 16));
      bm = fmaxf(bm, __shfl_xor(bm, 32));
      const float mnew = fmaxf(mref, bm);
      const float f = __expf(mref - mnew);
      lsum *= f;
#pragma unroll
      for (int j = 0; j < 4; ++j) {
        const float fj = __shfl(f, fq * 4 + j);
#pragma unroll
        for (int nt = 0; nt < 4; ++nt) O[nt][j] *= fj;
      }
      mref = mnew;
    }
    float pv[8];
#pragma unroll
    for (int j = 0; j < 4; ++j) {
      pv[j] = __expf(sa[j] - mref);
      pv[4 + j] = __expf(sb[j] - mref);
      lsum += pv[j] + pv[4 + j];
    }
    bf16x8 pa;
#pragma unroll
    for (int j = 0; j < 8; ++j) pa[j] = (short)f2bf(pv[j]);
    const u16* vb;
    size_t tstride;
    if (kb < nloc) {
      vb = p.vtL + ((size_t)(b * 1024 + h * 64 + fr)) * SEQ + (y0 + kb) * 64 + c0 + fq * 4;
      tstride = SEQ;
    } else {
      vb = p.vtC + ((size_t)(b * 1024 + h * 64 + fr)) * CTX + (kb - nloc) * 32 + fq * 4;
      tstride = CTX;
    }
#pragma unroll
    for (int nt = 0; nt < 4; ++nt) {
      const u16* vp = vb + (size_t)(nt * 16) * tstride;
      uint2 lo = *(const uint2*)(vp);
      uint2 hi = *(const uint2*)(vp + 16);
      bf16x8 bv;
      bv[0] = (short)(lo.x & 0xffff); bv[1] = (short)(lo.x >> 16); bv[2] = (short)(lo.y & 0xffff); bv[3] = (short)(lo.y >> 16);
      bv[4] = (short)(hi.x & 0xffff); bv[5] = (short)(hi.x >> 16); bv[6] = (short)(hi.y & 0xffff); bv[7] = (short)(hi.y >> 16);
      O[nt] = __builtin_amdgcn_mfma_f32_16x16x32_bf16(pa, bv, O[nt], 0, 0, 0);
    }
  }
  lsum += __shfl_xor(lsum, 16);
  lsum += __shfl_xor(lsum, 32);
  float inv = 1.f / lsum;
  float invq[4];
#pragma unroll
  for (int j = 0; j < 4; ++j) invq[j] = __shfl(inv, fq * 4 + j);
#pragma unroll
  for (int j = 0; j < 4; ++j) {
    size_t row = qrow0 + fq * 4 + j;
    const u16* gp = P + row * EV_IN + 7424 + h * 64 + fr;
    u16* yp = p.y + row * 2048 + 1024 + h * 64 + fr;
#pragma unroll
    for (int nt = 0; nt < 4; ++nt) {
      float g = bf2f(gp[nt * 16]);
      yp[nt * 16] = f2bf(O[nt][j] * invq[j] * siluf_(g));
    }
  }
}

__device__ void natten_phase(int tid_, int bid_, int nblk_, const Params& p, int li) {
  const int w = __builtin_amdgcn_readfirstlane(tid_ >> 6);
  const int nbt = (16384 + 1024) / 4;
  for (int bt = bid_; bt < nbt; bt += nblk_) natten_tile(tid_, bid_, nblk_, p, li, bt * 4 + w);
}

__device__ void mix_phase(int tid_, int bid_, int nblk_, const Params& p, int li, char* smem) {
  if (nblk_ >= 512) {
    if (bid_ < 256) rwkv_scan_item(tid_, bid_, nblk_, p, li, bid_, smem);
  } else {
    for (int item = bid_; item < 256; item += nblk_) rwkv_scan_item(tid_, bid_, nblk_, p, li, item, smem);
  }
  const int w = __builtin_amdgcn_readfirstlane(tid_ >> 6);
  const int nbt = (16384 + 1024) / 4;
  int* slot = (int*)(smem + SMEM_BYTES - 16);
  int* head = p.cnt + li * 16;
  while (true) {
    __syncthreads();
    if (tid_ == 0) *slot = __hip_atomic_fetch_add(head, 1, __ATOMIC_RELAXED, __HIP_MEMORY_SCOPE_AGENT);
    __syncthreads();
    const int bt = *slot;
    if (bt < nbt) { natten_tile(tid_, bid_, nblk_, p, li, bt * 4 + w); continue; }
    if (li != 0) break;
    int j = bt - nbt;
    float* sm = (float*)smem;
    if (j < 264) { transpose_job64(tid_, j, 264, p.ev_w_in + (size_t)2048 * EV_IN, p.wt_ev_in + (size_t)2048 * EV_IN, 2048, EV_IN, 1, 0, 0, 2048, sm); continue; }
    j -= 264;
    if (j < 128) { transpose_job64(tid_, j, 128, p.ev_w_out, p.wt_ev_out, 2048, 2048, 2, (size_t)2048 * 2048, (size_t)2048 * 2048, 2048, sm); continue; }
    j -= 128;
    if (j < 320) { transpose_job64(tid_, j, 320, p.od_w_in, p.wt_od_in, 2048, OD_IN, 2, (size_t)2048 * OD_IN, (size_t)2048 * OD_IN, 2048, sm); continue; }
    j -= 320;
    if (j < 160) { transpose_job64(tid_, j, 160, p.od_w_out, p.wt_od_out, DC, 2048, 2, (size_t)DC * 2048, (size_t)DC * 2048, DC, sm); continue; }
    j -= 160;
    if (j < 100) { transpose_job(tid_, j, 100, p.od_ga_w, p.wt_gate, 160, 160, 64, 25600, 51200, 160, sm); continue; }
    j -= 100;
    if (j < 100) { transpose_job(tid_, j, 100, p.od_gx_w, p.wt_gate + 25600, 160, 160, 64, 25600, 51200, 160, sm); continue; }
    j -= 100;
    if (j < 288) { mod_phase(tid_, j, 288, p, smem, 96, 384); continue; }
    break;
  }
}

__device__ void readout_phase(int tid_, int bid_, int nblk_, const Params& p, int li) {
  const int lane = tid_ & 63, w = __builtin_amdgcn_readfirstlane(tid_ >> 6);
  const int gw = bid_ * 4 + w, nw = nblk_ * 4;
  const int h = lane >> 2, q = lane & 3;
  const int cbase = h * 64 + q * 16;
  const float* mu0 = p.ev_mu + (size_t)li * 2 * 3328 + 2048 + cbase;
  const float* mu1 = mu0 + 3328;
  for (int row = gw; row < MTOT; row += nw) {
    int t, T;
    if (row < MLAT) { t = row & 4095; T = SEQ; } else { t = (row - MLAT) & 255; T = CTX; }
    float o[16];
    const float* of = p.o_scan + (size_t)row * DA + cbase;
    const float* ob = p.o_scan + ((size_t)MTOT + row) * DA + cbase;
    float sum = 0.f;
#pragma unroll
    for (int i = 0; i < 4; ++i) {
      float4 a = *(const float4*)(of + i * 4);
      float4 c = *(const float4*)(ob + i * 4);
      o[i * 4 + 0] = a.x + c.x; o[i * 4 + 1] = a.y + c.y; o[i * 4 + 2] = a.z + c.z; o[i * 4 + 3] = a.w + c.w;
      sum += o[i * 4 + 0] + o[i * 4 + 1] + o[i * 4 + 2] + o[i * 4 + 3];
    }
    sum += __shfl_xor(sum, 1);
    sum += __shfl_xor(sum, 2);
    float mean = sum * (1.f / 64.f);
    float vs = 0.f;
#pragma unroll
    for (int i = 0; i < 16; ++i) { float d = o[i] - mean; vs += d * d; }
    vs += __shfl_xor(vs, 1);
    vs += __shfl_xor(vs, 2);
    float rstd = rsqrtf(vs * (1.f / 64.f) + 64e-5f);
    float rks = p.rk[(size_t)row * 16 + h] + p.rk[((size_t)MTOT + row) * 16 + h];
    const u16* pv = p.P + (size_t)row * EV_IN + 2048 + cbase;
    const u16* pg = p.P + (size_t)row * EV_IN + 3328 + cbase;
    u16* yp = p.y + (size_t)row * 2048 + cbase;
#pragma unroll
    for (int half = 0; half < 2; ++half) {
      uint4 cv = *(const uint4*)(pv + half * 8);
      uint4 pvv = (t > 0) ? *(const uint4*)(pv - EV_IN + half * 8) : make_uint4(0, 0, 0, 0);
      uint4 nv = (t < T - 1) ? *(const uint4*)(pv + EV_IN + half * 8) : make_uint4(0, 0, 0, 0);
      uint4 gv = *(const uint4*)(pg + half * 8);
      unsigned cw[4] = {cv.x, cv.y, cv.z, cv.w}, pw[4] = {pvv.x, pvv.y, pvv.z, pvv.w};
      unsigned nw4[4] = {nv.x, nv.y, nv.z, nv.w}, gw4[4] = {gv.x, gv.y, gv.z, gv.w};
      unsigned outw[4];
#pragma unroll
      for (int e = 0; e < 4; ++e) {
        float res[2];
#pragma unroll
        for (int hh = 0; hh < 2; ++hh) {
          int ci = half * 8 + e * 2 + hh;
          float c = hh ? bfhi(cw[e]) : bflo(cw[e]);
          float pp = hh ? bfhi(pw[e]) : bflo(pw[e]);
          float nn = hh ? bfhi(nw4[e]) : bflo(nw4[e]);
          float g = hh ? bfhi(gw4[e]) : bflo(gw4[e]);
          float vsh = c + mu0[ci] * (pp - c) + mu1[ci] * (nn - c);
          float on = (o[ci] - mean) * rstd * p.ev_gn_w[li * DA + cbase + ci] + p.ev_gn_b[li * DA + cbase + ci];
          res[hh] = (on + rks * vsh) * siluf_(g);
        }
        outw[e] = pack2(res[0], res[1]);
      }
      *(uint4*)(yp + half * 8) = make_uint4(outw[0], outw[1], outw[2], outw[3]);
    }
  }
}

__device__ void odd_tiles(int tid_, int bid_, int nblk_, const Params& p, int oi, int mode, bool skip_ctx, char* smem) {
  const int tid = tid_, lane = tid & 63, w = __builtin_amdgcn_readfirstlane(tid >> 6);
  const int fr = lane & 15, fq = lane >> 4;
  u16* sU = (u16*)smem;
  float* sA = (float*)(smem + 32 * 168 * 2);
  float* sB = sA + 32 * 160;
  float* sHf = sB + 32 * 160;
  const int ntiles = NB * NCH * 16;
  const int mt = w & 1, nh = w >> 1;
  uint2 xr[5][4];
#define ODD_DECODE(TILE)                                                              \
  const int blk = (TILE) & 15, cgl = ((TILE) >> 4) % NCH, b = ((TILE) >> 4) / NCH;    \
  int rowbase, T, t0;                                                                 \
  if (cgl < 8) { rowbase = MLAT + b * CTX; T = CTX; t0 = cgl * 32; }                  \
  else { rowbase = b * SEQ; T = SEQ; t0 = (cgl - 8) * 32; }                           \
  const int cb = blk * 160;
#define ODD_PREFETCH(TILE)                                                            \
  {                                                                                   \
    ODD_DECODE(TILE)                                                                  \
    _Pragma("unroll") for (int i = 0; i < 5; ++i) {                                   \
      int e = tid + i * 256, t = e / 40, c4 = (e % 40) * 4;                           \
      _Pragma("unroll") for (int j = 0; j < 4; ++j) {                                 \
        int tt = t0 + t - 2 + j;                                                      \
        xr[i][j] = (tt >= 0 && tt < T)                                                \
                       ? *(const uint2*)(p.P + (size_t)(rowbase + tt) * OD_IN + cb + c4) \
                       : make_uint2(0u, 0u);                                          \
      }                                                                               \
    }                                                                                 \
  }
  int tile = bid_;
  while (tile < ntiles && skip_ctx && ((tile >> 4) % NCH) < 8) tile += nblk_;
  if (tile < ntiles) ODD_PREFETCH(tile)
  while (tile < ntiles) {
    ODD_DECODE(tile)
#pragma unroll
    for (int i = 0; i < 5; ++i) {
      int e = tid + i * 256, t = e / 40, c4 = (e % 40) * 4;
      float4 acc = *(const float4*)(p.od_conv_b + oi * DC + cb + c4);
#pragma unroll
      for (int j = 0; j < 4; ++j) {
        uint2 xv = xr[i][j];
        float4 wv = *(const float4*)(p.od_conv_w + ((size_t)oi * 4 + j) * DC + cb + c4);
        acc.x += bflo(xv.x) * wv.x; acc.y += bfhi(xv.x) * wv.y; acc.z += bflo(xv.y) * wv.z; acc.w += bfhi(xv.y) * wv.w;
      }
      uint2 o;
      o.x = pack2(acc.x, acc.y);
      o.y = pack2(acc.z, acc.w);
      *(uint2*)(sU + t * 168 + c4) = o;
    }
    lds_barrier();
    int nxt = tile + nblk_;
    while (nxt < ntiles && skip_ctx && ((nxt >> 4) % NCH) < 8) nxt += nblk_;
    if (nxt < ntiles) ODD_PREFETCH(nxt)
    float cin0 = 0.f, cin1 = 0.f;
    uint2 gv[5];
    unsigned* abrow;
    {
      const int r0 = rowbase + t0;
      abrow = ((r0 < AB_R1) ? (p.abA + (size_t)r0 * DC) : (p.abB + (size_t)(r0 - AB_R1) * DC)) + cb;
    }
    if (mode == 1) {
      if (tid < 160) {
        const size_t sidx0 = ((size_t)((b * NCH + cgl) * 2 + 0)) * DC + cb + tid;
        cin0 = p.carry[sidx0];
        cin1 = p.carry[sidx0 + DC];
      }
#pragma unroll
      for (int i = 0; i < 5; ++i) {
        int e = tid + i * 256, t = e / 40, c4 = (e % 40) * 4;
        gv[i] = *(const uint2*)(p.P + (size_t)(rowbase + t0 + t) * OD_IN + DC + cb + c4);
      }
    }
    bf16x8 au[5];
#pragma unroll
    for (int ks = 0; ks < 5; ++ks) au[ks] = *(const bf16x8*)(sU + (mt * 16 + fr) * 168 + ks * 32 + fq * 8);
    for (int d = 0; d < 2; ++d) {
      const u16* Wg = p.wt_gate + ((size_t)((oi * 2 + d) * 16 + blk)) * 320 * 160;
      const float* gab = p.od_ga_b + (size_t)(oi * 2 + d) * DC + cb;
      const float* gxb = p.od_gx_b + (size_t)(oi * 2 + d) * DC + cb;
      const float* lam = p.od_lambda + (size_t)(oi * 2 + d) * DC + cb;
      float bavv[5], bxvv[5], splv[5];
#pragma unroll
      for (int q = 0; q < 5; ++q) {
        const int c = (nh * 5 + q) * 16 + fr;
        bavv[q] = gab[c];
        bxvv[q] = gxb[c];
        splv[q] = lam[c];
      }
      if (mode == 1 && d == 0) {
#pragma unroll
        for (int i = 0; i < 5; ++i) {
          int e = tid + i * 256, t = e / 40, c4 = (e % 40) * 4;
          const uint4 abq = *(const uint4*)(abrow + (size_t)t * DC + c4);
          unsigned wv[4] = {abq.x, abq.y, abq.z, abq.w};
          float av[4], bv4[4];
#pragma unroll
          for (int q = 0; q < 4; ++q) { av[q] = __expf(h2f_bits(wv[q])); bv4[q] = h2f_bits(wv[q] >> 16); }
          *(float4*)(sA + t * 160 + c4) = make_float4(av[0], av[1], av[2], av[3]);
          *(float4*)(sB + t * 160 + c4) = make_float4(bv4[0], bv4[1], bv4[2], bv4[3]);
        }
      } else {
      bf16x8 bA[5], bX[5];
      {
        const u16* wa = Wg + (size_t)(nh * 5 * 16 + fr) * 160 + fq * 8;
#pragma unroll
        for (int ks = 0; ks < 5; ++ks) {
          bA[ks] = *(const bf16x8*)(wa + ks * 32);
          bX[ks] = *(const bf16x8*)(wa + (size_t)160 * 160 + ks * 32);
        }
      }
#pragma unroll
      for (int nti = 0; nti < 5; ++nti) {
        const int nt = nh * 5 + nti;
        f32x4 accA = {0.f, 0.f, 0.f, 0.f}, accX = {0.f, 0.f, 0.f, 0.f};
#pragma unroll
        for (int ks = 0; ks < 5; ++ks) {
          accA = __builtin_amdgcn_mfma_f32_16x16x32_bf16(au[ks], bA[ks], accA, 0, 0, 0);
          accX = __builtin_amdgcn_mfma_f32_16x16x32_bf16(au[ks], bX[ks], accX, 0, 0, 0);
        }
        if (nti + 1 < 5) {
          const u16* wa = Wg + (size_t)((nt + 1) * 16 + fr) * 160 + fq * 8;
#pragma unroll
          for (int ks = 0; ks < 5; ++ks) {
            bA[ks] = *(const bf16x8*)(wa + ks * 32);
            bX[ks] = *(const bf16x8*)(wa + (size_t)160 * 160 + ks * 32);
          }
        }
        const int c = nt * 16 + fr;
        const float bav = bavv[nti], bxv = bxvv[nti];
        const float spl = softplusf_(-splv[nti]);
#pragma unroll
        for (int j = 0; j < 4; ++j) {
          int t = mt * 16 + fq * 4 + j;
          float gr = sigmoidf_(accA[j] + bav);
          float gi = sigmoidf_(accX[j] + bxv);
          float la = -8.f * gr * spl;
          float a = __expf(la);
          float uu = bf2f(sU[t * 168 + c]);
          float bb = __builtin_amdgcn_sqrtf(fmaxf(1.f - a * a, 0.f)) * gi * uu;
          if (d == 0) {
            const unsigned hl = f2h_bits(la), hb = f2h_bits(bb);
            a = __expf(h2f_bits(hl));
            bb = h2f_bits(hb);
            if (mode == 0) abrow[(size_t)t * DC + c] = hl | (hb << 16);
          }
          sA[t * 160 + c] = a;
          sB[t * 160 + c] = bb;
        }
      }
      }
      lds_barrier();
      if (tid < 160) {
        const int c = tid;
        const size_t sidx = ((size_t)((b * NCH + cgl) * 2 + d)) * DC + cb + c;
        if (mode == 0) {
          float hacc = 0.f, ap = 1.f;
#pragma unroll 4
          for (int s = 0; s < 32; ++s) {
            int t = d ? 31 - s : s;
            float a = sA[t * 160 + c];
            hacc = a * hacc + sB[t * 160 + c];
            ap *= a;
          }
          p.summ[sidx * 2] = ap;
          p.summ[sidx * 2 + 1] = hacc;
        } else {
          float hacc = d ? cin1 : cin0;
          float* dst = d ? sB : sHf;
#pragma unroll 4
          for (int s = 0; s < 32; ++s) {
            int t = d ? 31 - s : s;
            hacc = sA[t * 160 + c] * hacc + sB[t * 160 + c];
            dst[t * 160 + c] = hacc;
          }
        }
      }
      lds_barrier();
    }
    if (mode == 1) {
#pragma unroll
      for (int i = 0; i < 5; ++i) {
        int e = tid + i * 256, t = e / 40, c4 = (e % 40) * 4;
        size_t row = (size_t)(rowbase + t0 + t);
        float4 hf = *(const float4*)(sHf + t * 160 + c4);
        float4 hb = *(const float4*)(sB + t * 160 + c4);
        float y0 = (hf.x + hb.x) * siluf_(bflo(gv[i].x));
        float y1 = (hf.y + hb.y) * siluf_(bfhi(gv[i].x));
        float y2 = (hf.z + hb.z) * siluf_(bflo(gv[i].y));
        float y3 = (hf.w + hb.w) * siluf_(bfhi(gv[i].y));
        uint2 o;
        o.x = pack2(y0, y1);
        o.y = pack2(y2, y3);
        *(uint2*)(p.y + row * DC + cb + c4) = o;
      }
      lds_barrier();
    }
    tile = nxt;
  }
#undef ODD_DECODE
#undef ODD_PREFETCH
}

__device__ void odd_carry(int tid_, int bid_, int nblk_, const Params& p) {
  const int gt = bid_ * 256 + tid_;
  if (gt >= NB * 2 * DC) return;
  const int C = gt % DC, d = (gt / DC) & 1, b = gt / (2 * DC);
  float hcur = 0.f;
  for (int i = 0; i < NCH; ++i) {
    int cgl;
    if (d == 0) cgl = i;
    else cgl = (i < 8) ? (7 - i) : (NCH - 1 - (i - 8));
    size_t sidx = ((size_t)((b * NCH + cgl) * 2 + d)) * DC + C;
    p.carry[sidx] = hcur;
    hcur = p.summ[sidx * 2] * hcur + p.summ[sidx * 2 + 1];
  }
}

__device__ void run_phase(int tid_, int bid_, int nblk_, const Params& p, int ph, char* smem) {
#ifndef HALF_MASK
#define HALF_MASK 0
#endif
  {
    int type;
    if (ph == 0) type = 0;
    else if (ph == 1 || ph == 6 || ph == 12 || ph == 17 || ph == 23) type = 1;
    else if (ph == 2 || ph == 5 || ph == 7 || ph == 11 || ph == 13 || ph == 16 || ph == 18 || ph == 22) type = 2;
    else if (ph == 3 || ph == 14) type = 3;
    else if (ph == 4 || ph == 15) type = 4;
    else if (ph == 9 || ph == 20) type = 6;
    else type = 5;
    if ((HALF_MASK >> type) & 1) {
      if (bid_ >= 256) return;
      nblk_ = 256;
    }
  }
  if (ph == 0) {
    float* sm = (float*)smem;
    if (bid_ == 0 && tid_ < 64) p.cnt[tid_] = 0;
    transpose_job64(tid_, bid_, nblk_, p.ev_w_in, p.wt_ev_in, 2048, EV_IN, 1, (size_t)2048 * EV_IN, (size_t)2048 * EV_IN, 2048, sm);
    mod_phase(tid_, bid_, nblk_, p, smem, 0, 96);
    return;
  }
  if (ph == 1) { norm_phase(tid_, bid_, nblk_, p, -1, 0); return; }
  int L, s;
  if (ph <= 6) { L = 0; s = ph - 2; }
  else if (ph <= 12) { L = 1; s = ph - 7; }
  else if (ph <= 17) { L = 2; s = ph - 13; }
  else { L = 3; s = ph - 18; }
  const int i2 = L >> 1;
  if ((L & 1) == 0) {
    switch (s) {
      case 0:
        gemm_phase<1>(tid_, bid_, nblk_, p.h, D, p.wt_ev_in + (size_t)i2 * EV_IN * 2048, 2048, EV_IN, p.P, EV_IN, p.vtL, p.vtC, smem);
        break;
      case 1: mix_phase(tid_, bid_, nblk_, p, i2, smem); break;
      case 2: readout_phase(tid_, bid_, nblk_, p, i2); break;
      case 3:
        gemm_phase<2>(tid_, bid_, nblk_, p.y, 2048, p.wt_ev_out + (size_t)i2 * 2048 * 2048, 2048, 2048, p.z, 2048, nullptr, nullptr, smem);
        break;
      default: norm_phase(tid_, bid_, nblk_, p, L, L + 1); break;
    }
  } else {
    switch (s) {
      case 0:
        gemm_phase<0>(tid_, bid_, nblk_, p.h, D, p.wt_od_in + (size_t)i2 * OD_IN * 2048, 2048, OD_IN, p.P, OD_IN, nullptr, nullptr, smem);
        break;
      case 1: odd_tiles(tid_, bid_, nblk_, p, i2, 0, false, smem); break;
      case 2: odd_carry(tid_, bid_, nblk_, p); break;
      case 3: odd_tiles(tid_, bid_, nblk_, p, i2, 1, L == 3, smem); break;
      case 4:
        gemm_phase<2>(tid_, bid_, nblk_, p.y, DC, p.wt_od_out + (size_t)i2 * 2048 * DC, DC, 2048, p.z, 2048, nullptr, nullptr, smem,
                      (L == 3) ? MLAT / 128 : MTOT / 128);
        break;
      default: norm_phase(tid_, bid_, nblk_, p, L, L + 1); break;
    }
  }
}


#define XB_TMO      128
#define XB_XCNT(j)  (256  + 64 * (j))
#define XB_XSUB(j)  (1280 + 64 * (j))
#define XB_XGEN(j)  (2304 + 64 * (j))
#define XB_TOP      3328
#define XB_TOPGEN   3392
#define XCD_BAR_WORDS 3456
#define XB_SPIN_CAP (1u << 18)
#define LAS __attribute__((address_space(3)))

__device__ __forceinline__ unsigned xb_ld(unsigned* p) { return __hip_atomic_load(p, __ATOMIC_RELAXED, __HIP_MEMORY_SCOPE_AGENT); }
__device__ __forceinline__ unsigned xb_add(unsigned* p, unsigned v) { return __hip_atomic_fetch_add(p, v, __ATOMIC_RELAXED, __HIP_MEMORY_SCOPE_AGENT); }
__device__ __forceinline__ unsigned xb_xcc_id() { return (unsigned)__builtin_amdgcn_s_getreg((3 << 11) | 20) & 0xFu; }
#define XB_SPIN(cond, bar) do { unsigned _sp = 0; while (cond) { __builtin_amdgcn_s_sleep(1); \
    if ((++_sp & 255u) == 0u) { if (xb_ld(&(bar)[XB_TMO])) break; if (_sp > XB_SPIN_CAP) { atomicAdd(&(bar)[XB_TMO], 1u); break; } } } } while (0)

struct XcdBarrier {
  unsigned* bar; unsigned x;
  volatile LAS unsigned* st;
};

__device__ __forceinline__ XcdBarrier xcd_barrier_post(unsigned* bar, volatile LAS unsigned* st) {
  XcdBarrier b; b.bar = bar; b.x = xb_xcc_id(); b.st = st;
  if (threadIdx.x == 0) (void)xb_add(&bar[XB_XCNT(b.x)], 1u);
  return b;
}
__device__ __forceinline__ void xcd_barrier_complete(unsigned* bar, unsigned x, unsigned& nloc, unsigned& nx) {
  const unsigned G = gridDim.x * gridDim.y * gridDim.z;
  unsigned sum, cnt, mine, sp = 0u;
  for (;;) {
    sum = 0u; cnt = 0u; mine = 0u;
#pragma unroll
    for (unsigned j = 0; j < 16; ++j) { const unsigned c = xb_ld(&bar[XB_XCNT(j)]); sum += c; cnt += (c > 0u) ? 1u : 0u; mine = (j == x) ? c : mine; }
    if (sum == G) break;
    __builtin_amdgcn_s_sleep(1);
    if ((++sp & 255u) == 0u) { if (xb_ld(&bar[XB_TMO])) break; if (sp > XB_SPIN_CAP) { atomicAdd(&bar[XB_TMO], 1u); break; } }
  }
  nloc = mine > 0u ? mine : 1u; nx = cnt > 0u ? cnt : 1u;
}
__device__ __forceinline__ void xcd_barrier(const XcdBarrier& b) {
  asm volatile("s_waitcnt vmcnt(0)" ::: "memory");
  __syncthreads();
  if (threadIdx.x == 0) {
    unsigned* bar = b.bar;
    __builtin_amdgcn_s_waitcnt(0);
    unsigned nloc = b.st[0], nx = b.st[1];
    if (nloc == 0u) { xcd_barrier_complete(bar, b.x, nloc, nx); b.st[0] = nloc; b.st[1] = nx; }
    const unsigned old = xb_add(&bar[XB_XSUB(b.x)], 1u);
    const unsigned gen = old / nloc;
    if (old + 1u == (gen + 1u) * nloc) {
      __builtin_amdgcn_fence(__ATOMIC_RELEASE, "agent");
      asm volatile("s_waitcnt vmcnt(0)" ::: "memory");
      const unsigned og = xb_add(&bar[XB_TOP], 1u);
      const unsigned tg = og / nx;
      if (og + 1u == (tg + 1u) * nx) xb_add(&bar[XB_TOPGEN], 1u);
      else XB_SPIN(xb_ld(&bar[XB_TOPGEN]) == tg, bar);
      __builtin_amdgcn_fence(__ATOMIC_ACQUIRE, "agent");
      xb_add(&bar[XB_XGEN(b.x)], 1u);
      asm volatile("s_waitcnt vmcnt(0)" ::: "memory");
    } else {
      XB_SPIN(xb_ld(&bar[XB_XGEN(b.x)]) == gen, bar);
      __builtin_amdgcn_fence(__ATOMIC_ACQUIRE, "agent");
      asm volatile("s_waitcnt vmcnt(0)" ::: "memory");
    }
  }
  __syncthreads();
}

__global__ void __launch_bounds__(256, 2) fwd_megakernel(Params p) {
  __shared__ __attribute__((aligned(16))) char smem[SMEM_BYTES];
  cg::grid_group grid = cg::this_grid();
  volatile LAS unsigned* xst = (volatile LAS unsigned*)(smem + SMEM_BYTES - 32);
  if (threadIdx.x == 0) { xst[0] = 0u; xst[1] = 0u; }
  __syncthreads();
  const XcdBarrier xb = xcd_barrier_post(p.bar, xst);
  for (int ph = p.ph0; ph < p.ph1; ++ph) {
    int tid_ = threadIdx.x, bid_ = blockIdx.x, nblk_ = gridDim.x;
    asm volatile("" : "+v"(tid_), "+s"(bid_));
    run_phase(tid_, bid_, nblk_, p, ph, smem);
    if (ph + 1 < p.ph1) {
      if (p.ph0 < 0) grid.sync();
      xcd_barrier(xb);
    }
  }
}

extern "C" void kernel_launch(void* const* d_in, const int* in_sizes, int n_in, void* d_out, int out_size, void* d_ws,
                              size_t ws_size, hipStream_t stream) {
  static int grid_blocks = 0;
  if (!grid_blocks) {
    int dev = 0, cus = 0, per_cu = 0;
    hipGetDevice(&dev);
    hipDeviceGetAttribute(&cus, hipDeviceAttributeMultiprocessorCount, dev);
    hipOccupancyMaxActiveBlocksPerMultiprocessor(&per_cu, fwd_megakernel, 256, 0);
    if (per_cu > 2) per_cu = 2;
    if (per_cu < 1) per_cu = 1;
    grid_blocks = cus * per_cu;
  }
  Params p{};
  const float* const* in = (const float* const*)d_in;
  p.x = in[0]; p.c = in[1]; p.ctx = in[2]; p.c_ctx = in[3]; p.mod_w = in[4]; p.mod_b = in[5];
  p.norm_pre = in[6]; p.norm_post = in[7];
  p.ev_w_in = in[8]; p.ev_mu = in[9]; p.ev_w0 = in[10]; p.ev_w_up = in[11]; p.ev_a0 = in[12]; p.ev_a_up = in[13];
  p.ev_k_k = in[14]; p.ev_k_a = in[15]; p.ev_r_k = in[16]; p.ev_gn_w = in[17]; p.ev_gn_b = in[18]; p.ev_rpb = in[19];
  p.ev_w_out = in[20];
  p.od_w_in = in[21]; p.od_conv_w = in[22]; p.od_conv_b = in[23]; p.od_ga_w = in[24]; p.od_ga_b = in[25];
  p.od_gx_w = in[26]; p.od_gx_b = in[27]; p.od_lambda = in[28]; p.od_w_out = in[29];
  p.out = (float*)d_out;
  char* ws = (char*)d_ws;
  size_t off = 0;
  auto take = [&](size_t bytes) { char* r = ws + off; off += (bytes + 255) & ~(size_t)255; return r; };
  p.wt_ev_in = (u16*)take((size_t)2 * EV_IN * 2048 * 2);
  p.wt_ev_out = (u16*)take((size_t)2 * 2048 * 2048 * 2);
  p.wt_od_in = (u16*)take((size_t)2 * OD_IN * 2048 * 2);
  p.wt_od_out = (u16*)take((size_t)2 * 2048 * DC * 2);
  p.wt_gate = (u16*)take((size_t)64 * 320 * 160 * 2);
  p.mod = (float*)take((size_t)4 * 5 * 6144 * 4);
  p.xc = (float*)take((size_t)MCTX * D * 4);
  p.P = (u16*)take((size_t)MTOT * EV_IN * 2);
  p.z = (float*)p.P;
  p.y = (u16*)take((size_t)MTOT * DC * 2);
  p.vtL = (u16*)take((size_t)NB * 1024 * SEQ * 2);
  p.vtC = (u16*)take((size_t)NB * 1024 * CTX * 2);
  p.rk = (float*)take((size_t)2 * MTOT * 16 * 4);
  p.cnt = (int*)take(256);
  p.bar = (unsigned*)take((size_t)XCD_BAR_WORDS * 4);
  char* region = take((size_t)2 * MTOT * DA * 4);
  p.h = (u16*)region;
  p.o_scan = (float*)region;
  p.abA = (unsigned*)((char*)p.P + (size_t)MTOT * OD_IN * 2);
  p.abB = (unsigned*)region;
  p.summ = (float*)(region + (size_t)MTOT * D * 2);
  p.carry = p.summ + (size_t)NB * NCH * 2 * DC * 2;
  p.ph0 = 0;
  p.ph1 = 24;
  if (off > ws_size) {
    fprintf(stderr, "workspace too small: need %zu have %zu\n", off, ws_size);
    return;
  }
  (void)hipMemsetAsync(p.bar, 0, (size_t)XCD_BAR_WORDS * 4, stream);
  void* args[] = {&p};
  hipError_t e = hipLaunchCooperativeKernel((void*)fwd_megakernel, dim3(grid_blocks), dim3(256), args, 0, stream);
  if (e != hipSuccess) fprintf(stderr, "cooperative launch failed: %s (grid %d)\n", hipGetErrorString(e), grid_blocks);
}
```

```cpp
#include <hip/hip_runtime.h>
#include <hip/hip_bf16.h>
#include <hip/hip_cooperative_groups.h>
#include <cstdio>
namespace cg = cooperative_groups;

typedef unsigned short u16;
using bf16x8 = __attribute__((ext_vector_type(8))) short;
using f32x4 = __attribute__((ext_vector_type(4))) float;

constexpr int D = 2048, NB = 4, SEQ = 4096, CTX = 256;
constexpr int MLAT = NB * SEQ;
constexpr int MCTX = NB * CTX;
constexpr int MTOT = MLAT + MCTX;
constexpr int EV_IN = 8448, OD_IN = 5120, DC = 2560, DA = 1024;
constexpr int AB_R1 = 11264;
constexpr int NCH = 136;
#define HALF_MASK 0
constexpr int SMEM_BYTES = 72704;

struct Params {
  const float *x, *c, *ctx, *c_ctx, *mod_w, *mod_b, *norm_pre, *norm_post;
  const float *ev_w_in, *ev_mu, *ev_w0, *ev_w_up, *ev_a0, *ev_a_up, *ev_k_k, *ev_k_a, *ev_r_k, *ev_gn_w,
      *ev_gn_b, *ev_rpb, *ev_w_out;
  const float *od_w_in, *od_conv_w, *od_conv_b, *od_ga_w, *od_ga_b, *od_gx_w, *od_gx_b, *od_lambda, *od_w_out;
  float* out;
  u16 *wt_ev_in, *wt_ev_out, *wt_od_in, *wt_od_out, *wt_gate;
  float *mod, *xc;
  u16 *h, *P, *y, *vtL, *vtC;
  float *z, *o_scan, *rk, *summ, *carry;
  int* cnt;
  unsigned *abA, *abB;
  unsigned* bar;
  int ph0, ph1;
};

__device__ __forceinline__ u16 f2bf(float f) {
  unsigned u = __float_as_uint(f);
  u += 0x7fffu + ((u >> 16) & 1u);
  return (u16)(u >> 16);
}
__device__ __forceinline__ float bf2f(u16 h) { return __uint_as_float(((unsigned)h) << 16); }
__device__ __forceinline__ float bflo(unsigned v) { return __uint_as_float(v << 16); }
__device__ __forceinline__ float bfhi(unsigned v) { return __uint_as_float(v & 0xffff0000u); }
__device__ __forceinline__ unsigned pack2(float a, float b) { return (unsigned)f2bf(a) | ((unsigned)f2bf(b) << 16); }
__device__ __forceinline__ float sigmoidf_(float x) { return __builtin_amdgcn_rcpf(1.f + __expf(-x)); }
__device__ __forceinline__ float siluf_(float x) { return x * __builtin_amdgcn_rcpf(1.f + __expf(-x)); }
__device__ __forceinline__ float softplusf_(float x) { return fmaxf(x, 0.f) + __logf(1.f + __expf(-fabsf(x))); }
__device__ __forceinline__ float tanhf_(float x) { return 1.f - 2.f * __builtin_amdgcn_rcpf(1.f + __expf(2.f * x)); }

__device__ __forceinline__ unsigned f2h_bits(float x) { _Float16 h = (_Float16)x; return (unsigned)__builtin_bit_cast(unsigned short, h); }
__device__ __forceinline__ float h2f_bits(unsigned b) { return (float)__builtin_bit_cast(_Float16, (unsigned short)(b & 0xffffu)); }
template <int CTRL>
__device__ __forceinline__ float dpp_f(float v) {
  return __int_as_float(__builtin_amdgcn_update_dpp(0, __float_as_int(v), CTRL, 0xf, 0xf, true));
}
__device__ __forceinline__ float red8(float v) {
  v += dpp_f<0xB1>(v);
  v += dpp_f<0x4E>(v);
  v += dpp_f<0x141>(v);
  return v;
}
__device__ __forceinline__ float red16(float v) {
  v = red8(v);
  v += dpp_f<0x140>(v);
  return v;
}
__device__ __forceinline__ float wave_sum(float v) {
#pragma unroll
  for (int o = 32; o > 0; o >>= 1) v += __shfl_xor(v, o);
  return v;
}

__device__ __forceinline__ void lds_barrier() {
  asm volatile("s_waitcnt lgkmcnt(0)\n\ts_barrier" ::: "memory");
}

__device__ __forceinline__ int lds_byte(int r, int c) {
  int st = (r >> 4) * 2 + (c >> 5), rr = r & 15, cc = c & 31, ob = rr * 64 + cc * 2;
  return st * 1024 + (ob ^ (((ob >> 9) & 1) << 5));
}

__device__ void transpose_job(int tid_, int bid_, int nblk_, const float* __restrict__ src, u16* __restrict__ dst, int K, int N, int nbatch,
                              size_t sstride, size_t dstride, int ldd, float* sm) {
  const int tid = tid_;
  const int tk = K / 32, tn = N / 32, per = tk * tn, total = per * nbatch;
  for (int t = bid_; t < total; t += nblk_) {
    int bi = t / per, r = t % per, kt = r / tn, nt = r % tn;
    const float* s = src + (size_t)bi * sstride + (size_t)(kt * 32) * N + nt * 32;
#pragma unroll
    for (int i = 0; i < 4; ++i) {
      int kk = (tid >> 5) + 8 * i, nn = tid & 31;
      sm[kk * 33 + nn] = s[(size_t)kk * N + nn];
    }
    __syncthreads();
    {
      int n = tid >> 3, kc = tid & 7;
      float v0 = sm[(kc * 4 + 0) * 33 + n], v1 = sm[(kc * 4 + 1) * 33 + n];
      float v2 = sm[(kc * 4 + 2) * 33 + n], v3 = sm[(kc * 4 + 3) * 33 + n];
      uint2 o;
      o.x = pack2(v0, v1);
      o.y = pack2(v2, v3);
      *(uint2*)(dst + (size_t)bi * dstride + (size_t)(nt * 32 + n) * ldd + kt * 32 + kc * 4) = o;
    }
    __syncthreads();
  }
}

__device__ void transpose_job64(int tid_, int bid_, int nblk_, const float* __restrict__ src, u16* __restrict__ dst, int K, int N,
                                int nbatch, size_t sstride, size_t dstride, int ldd, float* sm) {
  const int tid = tid_;
  const int tk = K / 64, tn = N / 64, per = tk * tn, total = per * nbatch;
  for (int t = bid_; t < total; t += nblk_) {
    int bi = t / per, r = t % per, kt = r / tn, nt = r % tn;
    const float* s = src + (size_t)bi * sstride + (size_t)(kt * 64) * N + nt * 64;
#pragma unroll
    for (int i = 0; i < 16; ++i) {
      int kk = (tid >> 6) + 4 * i, nn = tid & 63;
      sm[kk * 65 + nn] = s[(size_t)kk * N + nn];
    }
    __syncthreads();
    {
      int n = tid >> 2, kc = tid & 3;
      unsigned o[8];
#pragma unroll
      for (int e = 0; e < 8; ++e) o[e] = pack2(sm[(kc * 16 + 2 * e) * 65 + n], sm[(kc * 16 + 2 * e + 1) * 65 + n]);
      u16* d = dst + (size_t)bi * dstride + (size_t)(nt * 64 + n) * ldd + kt * 64 + kc * 16;
      *(uint4*)(d) = make_uint4(o[0], o[1], o[2], o[3]);
      *(uint4*)(d + 8) = make_uint4(o[4], o[5], o[6], o[7]);
    }
    __syncthreads();
  }
}

__device__ void mod_phase(int tid_, int bid_, int nblk_, const Params& p, char* smem, int item0, int item1) {
  if (item0 + bid_ >= item1) return;
  float* sC = (float*)smem;
  float* sRed = sC + 5 * 2048;
  const int tid = tid_;
  for (int i = tid; i < 5 * 2048; i += 256) {
    int r = i / 2048, k = i % 2048;
    float v = (r < 4) ? p.c[r * 2048 + k] : p.c_ctx[k];
    sC[i] = siluf_(v);
  }
  __syncthreads();
  for (int item = item0 + bid_; item < item1; item += nblk_) {
    int layer = item / 96, col0 = (item % 96) * 64;
    const float* W = p.mod_w + (size_t)layer * 2048 * 6144;
    int kg = tid >> 4, cl = tid & 15, col = col0 + cl * 4;
    float acc[5][4];
#pragma unroll
    for (int r = 0; r < 5; ++r)
#pragma unroll
      for (int e = 0; e < 4; ++e) acc[r][e] = 0.f;
    for (int k = kg * 128; k < kg * 128 + 128; ++k) {
      float4 w4 = *(const float4*)(W + (size_t)k * 6144 + col);
#pragma unroll
      for (int r = 0; r < 5; ++r) {
        float s = sC[r * 2048 + k];
        acc[r][0] += s * w4.x; acc[r][1] += s * w4.y; acc[r][2] += s * w4.z; acc[r][3] += s * w4.w;
      }
    }
#pragma unroll
    for (int r = 0; r < 5; ++r)
#pragma unroll
      for (int e = 0; e < 4; ++e) sRed[(kg * 5 + r) * 64 + cl * 4 + e] = acc[r][e];
    __syncthreads();
    for (int o = tid; o < 320; o += 256) {
      int r = o / 64, cc = o % 64;
      float s = 0.f;
#pragma unroll
      for (int g = 0; g < 16; ++g) s += sRed[(g * 5 + r) * 64 + cc];
      p.mod[(layer * 5 + r) * 6144 + col0 + cc] = s + p.mod_b[layer * 6144 + col0 + cc];
    }
    __syncthreads();
  }
}

__device__ void norm_phase(int tid_, int bid_, int nblk_, const Params& p, int lprev, int lnext) {
  const int lane = tid_ & 63, w = __builtin_amdgcn_readfirstlane(tid_ >> 6);
  const int gw = bid_ * 4 + w, nw = nblk_ * 4;
  for (int row = gw; row < MTOT; row += nw) {
    const bool isctx = row >= MLAT;
    if (isctx && lprev == 3) continue;
    const int mrow = isctx ? 4 : row / SEQ;
    const float* xold;
    float* xnew;
    if (!isctx) {
      xold = (lprev <= 0 ? p.x : p.out) + (size_t)row * D;
      xnew = p.out + (size_t)row * D;
    } else {
      int cr = row - MLAT;
      xold = (lprev <= 0 ? p.ctx : p.xc) + (size_t)cr * D;
      xnew = p.xc + (size_t)cr * D;
    }
    float xv[32];
#pragma unroll
    for (int i = 0; i < 8; ++i) {
      float4 v = *(const float4*)(xold + i * 256 + lane * 4);
      xv[i * 4 + 0] = v.x; xv[i * 4 + 1] = v.y; xv[i * 4 + 2] = v.z; xv[i * 4 + 3] = v.w;
    }
    if (lprev >= 0) {
      const float* zr = p.z + (size_t)row * D;
      float zv[32];
      float ss = 0.f;
#pragma unroll
      for (int i = 0; i < 8; ++i) {
        float4 v = *(const float4*)(zr + i * 256 + lane * 4);
        zv[i * 4 + 0] = v.x; zv[i * 4 + 1] = v.y; zv[i * 4 + 2] = v.z; zv[i * 4 + 3] = v.w;
        ss += v.x * v.x + v.y * v.y + v.z * v.z + v.w * v.w;
      }
      ss = wave_sum(ss);
      float rs = rsqrtf(ss * (1.f / 2048.f) + 1e-6f);
      const float* gate = p.mod + (lprev * 5 + mrow) * 6144 + 4096;
      const float* np = p.norm_post + lprev * D;
#pragma unroll
      for (int i = 0; i < 8; ++i) {
        int idx = i * 256 + lane * 4;
        float4 g4 = *(const float4*)(gate + idx);
        float4 n4 = *(const float4*)(np + idx);
        xv[i * 4 + 0] += g4.x * (zv[i * 4 + 0] * rs * n4.x);
        xv[i * 4 + 1] += g4.y * (zv[i * 4 + 1] * rs * n4.y);
        xv[i * 4 + 2] += g4.z * (zv[i * 4 + 2] * rs * n4.z);
        xv[i * 4 + 3] += g4.w * (zv[i * 4 + 3] * rs * n4.w);
        float4 o;
        o.x = xv[i * 4 + 0]; o.y = xv[i * 4 + 1]; o.z = xv[i * 4 + 2]; o.w = xv[i * 4 + 3];
        *(float4*)(xnew + idx) = o;
      }
    }
    if (lnext <= 3) {
      float ss = 0.f;
#pragma unroll
      for (int i = 0; i < 32; ++i) ss += xv[i] * xv[i];
      ss = wave_sum(ss);
      float rs = rsqrtf(ss * (1.f / 2048.f) + 1e-6f);
      const float* shift = p.mod + (lnext * 5 + mrow) * 6144;
      const float* scale = shift + 2048;
      const float* npre = p.norm_pre + lnext * D;
      u16* hr = p.h + (size_t)row * D;
#pragma unroll
      for (int i = 0; i < 8; ++i) {
        int idx = i * 256 + lane * 4;
        float4 s4 = *(const float4*)(shift + idx);
        float4 c4 = *(const float4*)(scale + idx);
        float4 n4 = *(const float4*)(npre + idx);
        float h0 = xv[i * 4 + 0] * rs * n4.x * (1.f + c4.x) + s4.x;
        float h1 = xv[i * 4 + 1] * rs * n4.y * (1.f + c4.y) + s4.y;
        float h2 = xv[i * 4 + 2] * rs * n4.z * (1.f + c4.z) + s4.z;
        float h3 = xv[i * 4 + 3] * rs * n4.w * (1.f + c4.w) + s4.w;
        uint2 o;
        o.x = pack2(h0, h1);
        o.y = pack2(h2, h3);
        *(uint2*)(hr + idx) = o;
      }
    }
  }
}

template <int MODE>
__device__ void gemm_phase(int tid_, int bid_, int nblk_, const u16* __restrict__ A, int lda, const u16* __restrict__ Bt, int K, int N, void* Cout,
                           int ldc, u16* vtL, u16* vtC, char* smem, int MT = MTOT / 128) {
  const int tid = tid_, lane = tid & 63, wid = __builtin_amdgcn_readfirstlane(tid >> 6);
  const int wm = wid >> 1, wn = wid & 1, fr = lane & 15, fq = lane >> 4;
  const int NT = N / 128, ntiles = MT * NT, nk = K / 64;
  const int GM = 8, nig = GM * NT;
  const int pr = tid >> 3, pc8 = tid & 7;
  const int bpx = nblk_ >> 3;
  for (int it = 0; (it * 8) * bpx < ntiles; ++it) {
    const int tile = (it * 8 + (bid_ & 7)) * bpx + (bid_ >> 3);
    if (tile >= ntiles) continue;
    int gid = tile / nig, fm = gid * GM;
    int pm = fm + (tile % nig) % GM, pn = (tile % nig) / GM;
    const int row0 = pm * 128, col0 = pn * 128;
    const u16* gA = A + (size_t)(row0 + pr) * lda + pc8 * 8;
    const u16* gB = Bt + (size_t)(col0 + pr) * K + pc8 * 8;
    f32x4 acc[4][4];
#pragma unroll
    for (int i = 0; i < 4; ++i)
#pragma unroll
      for (int j = 0; j < 4; ++j) acc[i][j] = f32x4{0.f, 0.f, 0.f, 0.f};
    const u16* srcA[4];
    const u16* srcB[4];
#pragma unroll
    for (int i = 0; i < 4; ++i) {
      int bb = tid * 16 + i * 4096;
      int st = bb >> 10, sb = bb & 1023, swz = sb ^ (((sb >> 9) & 1) << 5);
      int R = (st >> 1) * 16 + (swz >> 6), Cc = (st & 1) * 32 + ((swz & 63) >> 1);
      srcA[i] = A + (size_t)(row0 + R) * lda + Cc;
      srcB[i] = Bt + (size_t)(col0 + R) * K + Cc;
    }
    auto stage = [&](int kt, int BUF) {
#pragma unroll
      for (int i = 0; i < 4; ++i) {
        char* la = smem + BUF * 32768 + tid * 16 + i * 4096;
        __builtin_amdgcn_global_load_lds((const unsigned*)(srcA[i] + kt * 64),
                                         (__attribute__((address_space(3))) unsigned*)la, 16, 0, 0);
        __builtin_amdgcn_global_load_lds((const unsigned*)(srcB[i] + kt * 64),
                                         (__attribute__((address_space(3))) unsigned*)(la + 16384), 16, 0, 0);
      }
    };
    auto compute = [&](int BUF) {
      const char* sa = smem + BUF * 32768;
      const char* sb = sa + 16384;
      bf16x8 af[4][2], bfr[4][2];
#pragma unroll
      for (int ms = 0; ms < 4; ++ms)
#pragma unroll
        for (int ks = 0; ks < 2; ++ks)
          af[ms][ks] = *(const bf16x8*)(sa + lds_byte(wm * 64 + ms * 16 + fr, ks * 32 + fq * 8));
#pragma unroll
      for (int ns = 0; ns < 4; ++ns)
#pragma unroll
        for (int ks = 0; ks < 2; ++ks)
          bfr[ns][ks] = *(const bf16x8*)(sb + lds_byte(wn * 64 + ns * 16 + fr, ks * 32 + fq * 8));
      __builtin_amdgcn_s_setprio(1);
#pragma unroll
      for (int ks = 0; ks < 2; ++ks)
#pragma unroll
        for (int ms = 0; ms < 4; ++ms)
#pragma unroll
          for (int ns = 0; ns < 4; ++ns)
            acc[ms][ns] = __builtin_amdgcn_mfma_f32_16x16x32_bf16(bfr[ns][ks], af[ms][ks], acc[ms][ns], 0, 0, 0);
      __builtin_amdgcn_s_setprio(0);
    };
    stage(0, 0);
    asm volatile("s_waitcnt vmcnt(0)" ::: "memory");
    lds_barrier();
    for (int kt = 0; kt < nk; ++kt) {
      if (kt + 1 < nk) stage(kt + 1, (kt + 1) & 1);
      compute(kt & 1);
      asm volatile("s_waitcnt vmcnt(0)" ::: "memory");
      lds_barrier();
    }
    const bool vt = (MODE == 1) && (col0 >= 6400) && (col0 < 7424);
#pragma unroll
    for (int ms = 0; ms < 4; ++ms) {
      const int m = row0 + wm * 64 + ms * 16 + fr;
#pragma unroll
      for (int ns = 0; ns < 4; ++ns) {
        const int n = col0 + wn * 64 + ns * 16 + fq * 4;
        f32x4 v = acc[ms][ns];
        if (MODE == 2) {
          float4 o;
          o.x = v[0]; o.y = v[1]; o.z = v[2]; o.w = v[3];
          *(float4*)((float*)Cout + (size_t)m * ldc + n) = o;
        } else if (vt) {
          int cn = n - 6400;
          if (m < MLAT) {
            int b = m >> 12, t = m & 4095;
#pragma unroll
            for (int j = 0; j < 4; ++j) vtL[((size_t)(b * 1024 + cn + j)) * SEQ + t] = f2bf(v[j]);
          } else {
            int b = (m - MLAT) >> 8, t = (m - MLAT) & 255;
#pragma unroll
            for (int j = 0; j < 4; ++j) vtC[((size_t)(b * 1024 + cn + j)) * CTX + t] = f2bf(v[j]);
          }
        } else {
          uint2 o;
          o.x = pack2(v[0], v[1]);
          o.y = pack2(v[2], v[3]);
          *(uint2*)((u16*)Cout + (size_t)m * ldc + n) = o;
        }
      }
    }
  }
}

struct Pre {
  uint2 cur[5], prv[5], nxt[5];
};

__device__ __forceinline__ void chunk_info(int gc, int b, int dir, int& rowbase, int& T, int& tb) {
  int c;
  if (gc < 16) { rowbase = MLAT + b * CTX; T = CTX; c = gc; }
  else { rowbase = b * SEQ; T = SEQ; c = gc - 16; }
  tb = dir ? (T - 16 - c * 16) : (c * 16);
}

typedef float v2f __attribute__((ext_vector_type(2)));

typedef float v2f __attribute__((ext_vector_type(2)));

__device__ void rwkv_scan_item(int tid_, int bid_, int nblk_, const Params& p, int li, int item, char* smem) {
  const int half = item & 1, dir = (item >> 1) & 1, h = (item >> 2) & 15, b = item >> 6;
  const int tid = tid_, lane = tid & 63, w = __builtin_amdgcn_readfirstlane(tid >> 6);
  const int fr = lane & 15, fq = lane >> 4;
  float* sW = (float*)smem;
  float* sKK = sW + 1024;
  float* sKKA = sKK + 1024;
  float* sKD = sKKA + 1024;
  float* sR = sKD + 1024;
  float* sV = sR + 1024;
  float* sK = sV + 1024;
  float* sO = sK + 1024;
  u16* sAw = (u16*)(sO + 1024);
  u16* sAa = sAw + 16 * 72;
  float* sMu0 = (float*)(sAa + 16 * 72);
  float* sMu1 = sMu0 + 320;
  float* sKk = sMu1 + 320;
  float* sRk = sKk + 64;
  const u16* P = p.P;
  const int sA_s0 = tid >> 4, sA_cc0 = tid & 15;
  int goff[5];
  goff[0] = h * 64; goff[1] = 1024 + h * 64; goff[2] = 2048 + h * 64; goff[3] = 3072 + dir * 64; goff[4] = 3200 + dir * 64;
  __syncthreads();
  {
    const float* mu0 = p.ev_mu + (size_t)li * 2 * 3328;
    const float* mu1 = mu0 + 3328;
    for (int i = tid; i < 320; i += 256) {
      int g = i >> 6, c = i & 63;
      sMu0[i] = mu0[goff[g] + c];
      sMu1[i] = mu1[goff[g] + c];
    }
    if (tid < 64) {
      sKk[tid] = p.ev_k_k[li * DA + h * 64 + tid];
      sRk[tid] = p.ev_r_k[(li * 16 + h) * 64 + tid];
    }
  }
  const int keyB = 16 * w + fr;
  const float w0v = p.ev_w0[(li * 2 + dir) * DA + h * 64 + keyB];
  const float a0v = p.ev_a0[(li * 2 + dir) * DA + h * 64 + keyB];
  const float kav = p.ev_k_a[li * DA + h * 64 + keyB];
  bf16x8 bw[2], ba[2];
  {
    const float* wu = p.ev_w_up + (size_t)(li * 2 + dir) * 64 * DA + h * 64 + keyB;
    const float* au = p.ev_a_up + (size_t)(li * 2 + dir) * 64 * DA + h * 64 + keyB;
#pragma unroll
    for (int ks = 0; ks < 2; ++ks)
#pragma unroll
      for (int j = 0; j < 8; ++j) {
        int k = ks * 32 + fq * 8 + j;
        bw[ks][j] = (short)f2bf(wu[(size_t)k * DA]);
        ba[ks][j] = (short)f2bf(au[(size_t)k * DA]);
      }
  }
  const int rlC = 8 * w + (lane >> 3), ksC = lane & 7;
  const int vrowC = half * 32 + rlC;
  v2f S[4];
#pragma unroll
  for (int k = 0; k < 4; ++k) S[k] = v2f{0.f, 0.f};

  auto load_pre = [&](int gc, Pre& pre, int sA_s, int sA_cc) {
    int rowbase, T, tb;
    chunk_info(gc, b, dir, rowbase, T, tb);
    int t = dir ? (tb + 15 - sA_s) : (tb + sA_s);
    const u16* base = P + (size_t)(rowbase + t) * EV_IN + sA_cc * 4;
#pragma unroll
    for (int g = 0; g < 5; ++g) {
      pre.cur[g] = *(const uint2*)(base + goff[g]);
      pre.prv[g] = (t > 0) ? *(const uint2*)(base - EV_IN + goff[g]) : make_uint2(0u, 0u);
      pre.nxt[g] = (t < T - 1) ? *(const uint2*)(base + EV_IN + goff[g]) : make_uint2(0u, 0u);
    }
  };

  Pre pre;
  load_pre(0, pre, sA_s0, sA_cc0);
  __syncthreads();
  const int NGC = 16 + 256;
  for (int gc = 0; gc <= NGC; ++gc) {
    int sA_s = sA_s0, sA_cc = sA_cc0;
    asm volatile("" : "+v"(sA_s), "+v"(sA_cc));
    if (gc > 0) {
      int rowbase, T, tb;
      chunk_info(gc - 1, b, dir, rowbase, T, tb);
      if (tid < 128) {
        int s = tid >> 3, c4 = (tid & 7) * 4;
        int t = dir ? (tb + 15 - s) : (tb + s);
        float4 o4 = *(const float4*)(sO + s * 32 + c4);
        *(float4*)(p.o_scan + ((size_t)dir * MTOT + rowbase + t) * DA + h * 64 + half * 32 + c4) = o4;
      }
      if (half == ((gc - 1) & 1)) {
        int t = dir ? (tb + 15 - sA_s) : (tb + sA_s);
        size_t row = (size_t)(rowbase + t);
        float4 r4 = *(const float4*)(sR + sA_s * 64 + sA_cc * 4);
        float4 k4 = *(const float4*)(sKD + sA_s * 64 + sA_cc * 4);
        float4 q4 = *(const float4*)(sRk + sA_cc * 4);
        float s = r4.x * k4.x * q4.x + r4.y * k4.y * q4.y + r4.z * k4.z * q4.z + r4.w * k4.w * q4.w;
        s = red16(s);
        if (sA_cc == 0) p.rk[((size_t)dir * MTOT + row) * 16 + h] = s;
      }
    }
    if (gc == NGC) break;
    {
      float val[5][4];
#pragma unroll
      for (int g = 0; g < 5; ++g) {
        float4 m0 = *(const float4*)(sMu0 + g * 64 + sA_cc * 4);
        float4 m1 = *(const float4*)(sMu1 + g * 64 + sA_cc * 4);
        float c0 = bflo(pre.cur[g].x), c1 = bfhi(pre.cur[g].x), c2 = bflo(pre.cur[g].y), c3 = bfhi(pre.cur[g].y);
        float p0 = bflo(pre.prv[g].x), p1 = bfhi(pre.prv[g].x), p2 = bflo(pre.prv[g].y), p3 = bfhi(pre.prv[g].y);
        float n0 = bflo(pre.nxt[g].x), n1 = bfhi(pre.nxt[g].x), n2 = bflo(pre.nxt[g].y), n3 = bfhi(pre.nxt[g].y);
        val[g][0] = c0 + m0.x * (p0 - c0) + m1.x * (n0 - c0);
        val[g][1] = c1 + m0.y * (p1 - c1) + m1.y * (n1 - c1);
        val[g][2] = c2 + m0.z * (p2 - c2) + m1.z * (n2 - c2);
        val[g][3] = c3 + m0.w * (p3 - c3) + m1.w * (n3 - c3);
      }
      const int so = sA_s * 64 + sA_cc * 4;
      *(float4*)(sR + so) = make_float4(val[0][0], val[0][1], val[0][2], val[0][3]);
      *(float4*)(sK + so) = make_float4(val[1][0], val[1][1], val[1][2], val[1][3]);
      *(float4*)(sV + so) = make_float4(val[2][0], val[2][1], val[2][2], val[2][3]);
      float4 kk4 = *(const float4*)(sKk + sA_cc * 4);
      float q0 = val[1][0] * kk4.x, q1 = val[1][1] * kk4.y, q2 = val[1][2] * kk4.z, q3 = val[1][3] * kk4.w;
      float ss = red16(q0 * q0 + q1 * q1 + q2 * q2 + q3 * q3);
      float rn = rsqrtf(ss + 1e-12f);
      *(float4*)(sKK + so) = make_float4(q0 * rn, q1 * rn, q2 * rn, q3 * rn);
      uint2 tw, ta;
      tw.x = pack2(tanhf_(val[3][0]), tanhf_(val[3][1]));
      tw.y = pack2(tanhf_(val[3][2]), tanhf_(val[3][3]));
      ta.x = pack2(val[4][0], val[4][1]);
      ta.y = pack2(val[4][2], val[4][3]);
      *(uint2*)(sAw + sA_s * 72 + sA_cc * 4) = tw;
      *(uint2*)(sAa + sA_s * 72 + sA_cc * 4) = ta;
    }
    lds_barrier();
    if (gc + 1 < NGC) load_pre(gc + 1, pre, sA_s, sA_cc);
    {
      f32x4 dw = {0.f, 0.f, 0.f, 0.f}, da = {0.f, 0.f, 0.f, 0.f};
#pragma unroll
      for (int ks = 0; ks < 2; ++ks) {
        bf16x8 aw = *(const bf16x8*)(sAw + fr * 72 + ks * 32 + fq * 8);
        bf16x8 aa = *(const bf16x8*)(sAa + fr * 72 + ks * 32 + fq * 8);
        dw = __builtin_amdgcn_mfma_f32_16x16x32_bf16(aw, bw[ks], dw, 0, 0, 0);
        da = __builtin_amdgcn_mfma_f32_16x16x32_bf16(aa, ba[ks], da, 0, 0, 0);
      }
#pragma unroll
      for (int j = 0; j < 4; ++j) {
        int s = fq * 4 + j;
        float xw = dw[j] + w0v;
        float dec = __expf(-0.60653066f * sigmoidf_(xw));
        float a = sigmoidf_(a0v + da[j]);
        float kx = sK[s * 64 + keyB], kkx = sKK[s * 64 + keyB];
        sW[s * 64 + keyB] = dec;
        sKD[s * 64 + keyB] = kx * (1.f + (a - 1.f) * kav);
        sKKA[s * 64 + keyB] = kkx * a;
      }
    }
    lds_barrier();
    {
      float4 cur[10], nxt[10];
      float vcur, vnxt;
      {
        const int o8 = ksC * 8;
        cur[0] = *(const float4*)(sKK + o8); cur[1] = *(const float4*)(sKK + o8 + 4);
        cur[2] = *(const float4*)(sW + o8); cur[3] = *(const float4*)(sW + o8 + 4);
        cur[4] = *(const float4*)(sKKA + o8); cur[5] = *(const float4*)(sKKA + o8 + 4);
        cur[6] = *(const float4*)(sKD + o8); cur[7] = *(const float4*)(sKD + o8 + 4);
        cur[8] = *(const float4*)(sR + o8); cur[9] = *(const float4*)(sR + o8 + 4);
        vcur = sV[vrowC];
      }
#pragma unroll
      for (int s = 0; s < 16; ++s) {
        if (s + 1 < 16) {
          const int o8 = (s + 1) * 64 + ksC * 8;
          nxt[0] = *(const float4*)(sKK + o8); nxt[1] = *(const float4*)(sKK + o8 + 4);
          nxt[2] = *(const float4*)(sW + o8); nxt[3] = *(const float4*)(sW + o8 + 4);
          nxt[4] = *(const float4*)(sKKA + o8); nxt[5] = *(const float4*)(sKKA + o8 + 4);
          nxt[6] = *(const float4*)(sKD + o8); nxt[7] = *(const float4*)(sKD + o8 + 4);
          nxt[8] = *(const float4*)(sR + o8); nxt[9] = *(const float4*)(sR + o8 + 4);
          vnxt = sV[(s + 1) * 64 + vrowC];
        }
        v2f kk[4] = {v2f{cur[0].x, cur[0].y}, v2f{cur[0].z, cur[0].w}, v2f{cur[1].x, cur[1].y}, v2f{cur[1].z, cur[1].w}};
        v2f ww[4] = {v2f{cur[2].x, cur[2].y}, v2f{cur[2].z, cur[2].w}, v2f{cur[3].x, cur[3].y}, v2f{cur[3].z, cur[3].w}};
        v2f ka[4] = {v2f{cur[4].x, cur[4].y}, v2f{cur[4].z, cur[4].w}, v2f{cur[5].x, cur[5].y}, v2f{cur[5].z, cur[5].w}};
        v2f kd[4] = {v2f{cur[6].x, cur[6].y}, v2f{cur[6].z, cur[6].w}, v2f{cur[7].x, cur[7].y}, v2f{cur[7].z, cur[7].w}};
        v2f rr[4] = {v2f{cur[8].x, cur[8].y}, v2f{cur[8].z, cur[8].w}, v2f{cur[9].x, cur[9].y}, v2f{cur[9].z, cur[9].w}};
        v2f a0 = S[0] * kk[0], a1 = S[1] * kk[1];
        a0 = __builtin_elementwise_fma(S[2], kk[2], a0);
        a1 = __builtin_elementwise_fma(S[3], kk[3], a1);
        a0 += a1;
        const float sa = red8(a0.x + a0.y);
        const v2f nsa = v2f{-sa, -sa}, vv = v2f{vcur, vcur};
#pragma unroll
        for (int k = 0; k < 4; ++k) {
          v2f t = S[k] * ww[k];
          t = __builtin_elementwise_fma(vv, kd[k], t);
          S[k] = __builtin_elementwise_fma(nsa, ka[k], t);
        }
        v2f o0 = S[0] * rr[0], o1 = S[1] * rr[1];
        o0 = __builtin_elementwise_fma(S[2], rr[2], o0);
        o1 = __builtin_elementwise_fma(S[3], rr[3], o1);
        o0 += o1;
        const float ov = red8(o0.x + o0.y);
        sO[s * 32 + rlC] = ov;
        if (s + 1 < 16) {
#pragma unroll
          for (int q = 0; q < 10; ++q) cur[q] = nxt[q];
          vcur = vnxt;
        }
      }
    }
    lds_barrier();
  }
}

__device__ void natten_tile(int tid_, int bid_, int nblk_, const Params& p, int li, int wt) {
  const int lane = tid_ & 63, fr = lane & 15, fq = lane >> 4;
  const u16* P = p.P;
  int b, h, y = 0, x0 = 0, nloc;
  size_t qrow0;
  if (wt < 16384) {
    int xg = wt & 3; y = (wt >> 2) & 63; h = (wt >> 8) & 15; b = wt >> 12;
    x0 = xg * 16; nloc = 8;
    qrow0 = (size_t)b * SEQ + y * 64 + x0;
  } else {
    int t2 = wt - 16384;
    int qg = t2 & 15; h = (t2 >> 4) & 15; b = t2 >> 8;
    nloc = 0;
    qrow0 = (size_t)MLAT + b * CTX + qg * 16;
  }
  const int y0 = min(max(y - 4, 0), 56);
  const int c0 = (x0 == 0) ? 0 : (x0 == 16 ? 8 : (x0 == 32 ? 24 : 32));
  const int xq = x0 + fr;
  const int cs = min(max(xq - 8, 0), 48);
  const float* rpb = p.ev_rpb + (size_t)(li * 16 + h) * 15 * 31;
  bf16x8 bq[2];
  {
    const u16* qp = P + (qrow0 + fr) * EV_IN + 4352 + h * 64 + fq * 8;
    bq[0] = *(const bf16x8*)(qp);
    bq[1] = *(const bf16x8*)(qp + 32);
  }
  const int nblk = nloc + 8;
  auto key_base = [&](int kb) -> size_t {
    return (kb < nloc) ? ((size_t)b * SEQ + (y0 + kb) * 64 + c0) : ((size_t)MLAT + b * CTX + (kb - nloc) * 32);
  };
  auto scores = [&](int kb, f32x4& sa, f32x4& sb) {
    size_t kr = key_base(kb);
    const u16* kp = P + (kr + fr) * EV_IN + 5376 + h * 64 + fq * 8;
    bf16x8 a0 = *(const bf16x8*)(kp);
    bf16x8 a1 = *(const bf16x8*)(kp + 32);
    bf16x8 a2 = *(const bf16x8*)(kp + (size_t)16 * EV_IN);
    bf16x8 a3 = *(const bf16x8*)(kp + (size_t)16 * EV_IN + 32);
    sa = f32x4{0.f, 0.f, 0.f, 0.f};
    sb = f32x4{0.f, 0.f, 0.f, 0.f};
    sa = __builtin_amdgcn_mfma_f32_16x16x32_bf16(a0, bq[0], sa, 0, 0, 0);
    sa = __builtin_amdgcn_mfma_f32_16x16x32_bf16(a1, bq[1], sa, 0, 0, 0);
    sb = __builtin_amdgcn_mfma_f32_16x16x32_bf16(a2, bq[0], sb, 0, 0, 0);
    sb = __builtin_amdgcn_mfma_f32_16x16x32_bf16(a3, bq[1], sb, 0, 0, 0);
    if (kb < nloc) {
      const float* rb = rpb + (y0 + kb - y + 7) * 31;
#pragma unroll
      for (int j = 0; j < 4; ++j) {
        int kc = c0 + fq * 4 + j;
        int kc2 = kc + 16;
        bool v1 = (kc >= cs) && (kc < cs + 16);
        bool v2 = (kc2 >= cs) && (kc2 < cs + 16);
        float b1 = v1 ? rb[kc - xq + 15] : 0.f;
        float b2 = v2 ? rb[kc2 - xq + 15] : 0.f;
        sa[j] = v1 ? sa[j] * 0.125f + b1 : -1e30f;
        sb[j] = v2 ? sb[j] * 0.125f + b2 : -1e30f;
      }
    } else {
#pragma unroll
      for (int j = 0; j < 4; ++j) { sa[j] *= 0.125f; sb[j] *= 0.125f; }
    }
  };
  const float THR = 0.f;
  float mref = -1e30f;
  f32x4 O[4];
#pragma unroll
  for (int nt = 0; nt < 4; ++nt) O[nt] = f32x4{0.f, 0.f, 0.f, 0.f};
  float lsum = 0.f;
#pragma unroll 2
  for (int kb = 0; kb < nblk; ++kb) {
    f32x4 sa, sb;
    scores(kb, sa, sb);
    float bm = fmaxf(fmaxf(fmaxf(sa[0], sa[1]), fmaxf(sa[2], sa[3])), fmaxf(fmaxf(sb[0], sb[1]), fmaxf(sb[2], sb[3])));
    if (__any(bm > mref + THR)) {
      bm = fmaxf(bm, __shfl_xor(bm, 16));
      bm = fmaxf(bm, __shfl_xor(bm, 32));
      const float mnew = fmaxf(mref, bm);
      const float f = __expf(mref - mnew);
      lsum *= f;
#pragma unroll
      for (int j = 0; j < 4; ++j) {
        const float fj = __shfl(f, fq * 4 + j);
#pragma unroll
        for (int nt = 0; nt < 4; ++nt) O[nt][j] *= fj;
      }
      mref = mnew;
    }
    float pv[8];
#pragma unroll
    for (int j = 0; j < 4; ++j) {
      pv[j] = __expf(sa[j] - mref);
      pv[4 + j] = __expf(sb[j] - mref);
      lsum += pv[j] + pv[4 + j];
    }
    bf16x8 pa;
#pragma unroll
    for (int j = 0; j < 8; ++j) pa[j] = (short)f2bf(pv[j]);
    const u16* vb;
    size_t tstride;
    if (kb < nloc) {
      vb = p.vtL + ((size_t)(b * 1024 + h * 64 + fr)) * SEQ + (y0 + kb) * 64 + c0 + fq * 4;
      tstride = SEQ;
    } else {
      vb = p.vtC + ((size_t)(b * 1024 + h * 64 + fr)) * CTX + (kb - nloc) * 32 + fq * 4;
      tstride = CTX;
    }
#pragma unroll
    for (int nt = 0; nt < 4; ++nt) {
      const u16* vp = vb + (size_t)(nt * 16) * tstride;
      uint2 lo = *(const uint2*)(vp);
      uint2 hi = *(const uint2*)(vp + 16);
      bf16x8 bv;
      bv[0] = (short)(lo.x & 0xffff); bv[1] = (short)(lo.x >> 16); bv[2] = (short)(lo.y & 0xffff); bv[3] = (short)(lo.y >> 16);
      bv[4] = (short)(hi.x & 0xffff); bv[5] = (short)(hi.x >> 16); bv[6] = (short)(hi.y & 0xffff); bv[7] = (short)(hi.y >> 16);
      O[nt] = __builtin_amdgcn_mfma_f32_16x16x32_bf16(pa, bv, O[nt], 0, 0, 0);
    }
  }
  lsum += __shfl_xor(lsum, 16);
  lsum += __shfl_xor(lsum, 32);
  float inv = 1.f / lsum;
  float invq[4];
#pragma unroll
  for (int j = 0; j < 4; ++j) invq[j] = __shfl(inv, fq * 4 + j);
#pragma unroll
  for (int j = 0; j < 4; ++j) {
    size_t row = qrow0 + fq * 4 + j;
    const u16* gp = P + row * EV_IN + 7424 + h * 64 + fr;
    u16* yp = p.y + row * 2048 + 1024 + h * 64 + fr;
#pragma unroll
    for (int nt = 0; nt < 4; ++nt) {
      float g = bf2f(gp[nt * 16]);
      yp[nt * 16] = f2bf(O[nt][j] * invq[j] * siluf_(g));
    }
  }
}

__device__ void natten_phase(int tid_, int bid_, int nblk_, const Params& p, int li) {
  const int w = __builtin_amdgcn_readfirstlane(tid_ >> 6);
  const int nbt = (16384 + 1024) / 4;
  for (int bt = bid_; bt < nbt; bt += nblk_) natten_tile(tid_, bid_, nblk_, p, li, bt * 4 + w);
}

__device__ void mix_phase(int tid_, int bid_, int nblk_, const Params& p, int li, char* smem) {
  if (nblk_ >= 512) {
    if (bid_ < 256) rwkv_scan_item(tid_, bid_, nblk_, p, li, bid_, smem);
  } else {
    for (int item = bid_; item < 256; item += nblk_) rwkv_scan_item(tid_, bid_, nblk_, p, li, item, smem);
  }
  const int w = __builtin_amdgcn_readfirstlane(tid_ >> 6);
  const int nbt = (16384 + 1024) / 4;
  int* slot = (int*)(smem + SMEM_BYTES - 16);
  int* head = p.cnt + li * 16;
  while (true) {
    __syncthreads();
    if (tid_ == 0) *slot = __hip_atomic_fetch_add(head, 1, __ATOMIC_RELAXED, __HIP_MEMORY_SCOPE_AGENT);
    __syncthreads();
    const int bt = *slot;
    if (bt < nbt) { natten_tile(tid_, bid_, nblk_, p, li, bt * 4 + w); continue; }
    if (li != 0) break;
    int j = bt - nbt;
    float* sm = (float*)smem;
    if (j < 264) { transpose_job64(tid_, j, 264, p.ev_w_in + (size_t)2048 * EV_IN, p.wt_ev_in + (size_t)2048 * EV_IN, 2048, EV_IN, 1, 0, 0, 2048, sm); continue; }
    j -= 264;
    if (j < 128) { transpose_job64(tid_, j, 128, p.ev_w_out, p.wt_ev_out, 2048, 2048, 2, (size_t)2048 * 2048, (size_t)2048 * 2048, 2048, sm); continue; }
    j -= 128;
    if (j < 320) { transpose_job64(tid_, j, 320, p.od_w_in, p.wt_od_in, 2048, OD_IN, 2, (size_t)2048 * OD_IN, (size_t)2048 * OD_IN, 2048, sm); continue; }
    j -= 320;
    if (j < 160) { transpose_job64(tid_, j, 160, p.od_w_out, p.wt_od_out, DC, 2048, 2, (size_t)DC * 2048, (size_t)DC * 2048, DC, sm); continue; }
    j -= 160;
    if (j < 100) { transpose_job(tid_, j, 100, p.od_ga_w, p.wt_gate, 160, 160, 64, 25600, 51200, 160, sm); continue; }
    j -= 100;
    if (j < 100) { transpose_job(tid_, j, 100, p.od_gx_w, p.wt_gate + 25600, 160, 160, 64, 25600, 51200, 160, sm); continue; }
    j -= 100;
    if (j < 288) { mod_phase(tid_, j, 288, p, smem, 96, 384); continue; }
    break;
  }
}

__device__ void readout_phase(int tid_, int bid_, int nblk_, const Params& p, int li) {
  const int lane = tid_ & 63, w = __builtin_amdgcn_readfirstlane(tid_ >> 6);
  const int gw = bid_ * 4 + w, nw = nblk_ * 4;
  const int h = lane >> 2, q = lane & 3;
  const int cbase = h * 64 + q * 16;
  const float* mu0 = p.ev_mu + (size_t)li * 2 * 3328 + 2048 + cbase;
  const float* mu1 = mu0 + 3328;
  for (int row = gw; row < MTOT; row += nw) {
    int t, T;
    if (row < MLAT) { t = row & 4095; T = SEQ; } else { t = (row - MLAT) & 255; T = CTX; }
    float o[16];
    const float* of = p.o_scan + (size_t)row * DA + cbase;
    const float* ob = p.o_scan + ((size_t)MTOT + row) * DA + cbase;
    float sum = 0.f;
#pragma unroll
    for (int i = 0; i < 4; ++i) {
      float4 a = *(const float4*)(of + i * 4);
      float4 c = *(const float4*)(ob + i * 4);
      o[i * 4 + 0] = a.x + c.x; o[i * 4 + 1] = a.y + c.y; o[i * 4 + 2] = a.z + c.z; o[i * 4 + 3] = a.w + c.w;
      sum += o[i * 4 + 0] + o[i * 4 + 1] + o[i * 4 + 2] + o[i * 4 + 3];
    }
    sum += __shfl_xor(sum, 1);
    sum += __shfl_xor(sum, 2);
    float mean = sum * (1.f / 64.f);
    float vs = 0.f;
#pragma unroll
    for (int i = 0; i < 16; ++i) { float d = o[i] - mean; vs += d * d; }
    vs += __shfl_xor(vs, 1);
    vs += __shfl_xor(vs, 2);
    float rstd = rsqrtf(vs * (1.f / 64.f) + 64e-5f);
    float rks = p.rk[(size_t)row * 16 + h] + p.rk[((size_t)MTOT + row) * 16 + h];
    const u16* pv = p.P + (size_t)row * EV_IN + 2048 + cbase;
    const u16* pg = p.P + (size_t)row * EV_IN + 3328 + cbase;
    u16* yp = p.y + (size_t)row * 2048 + cbase;
#pragma unroll
    for (int half = 0; half < 2; ++half) {
      uint4 cv = *(const uint4*)(pv + half * 8);
      uint4 pvv = (t > 0) ? *(const uint4*)(pv - EV_IN + half * 8) : make_uint4(0, 0, 0, 0);
      uint4 nv = (t < T - 1) ? *(const uint4*)(pv + EV_IN + half * 8) : make_uint4(0, 0, 0, 0);
      uint4 gv = *(const uint4*)(pg + half * 8);
      unsigned cw[4] = {cv.x, cv.y, cv.z, cv.w}, pw[4] = {pvv.x, pvv.y, pvv.z, pvv.w};
      unsigned nw4[4] = {nv.x, nv.y, nv.z, nv.w}, gw4[4] = {gv.x, gv.y, gv.z, gv.w};
      unsigned outw[4];
#pragma unroll
      for (int e = 0; e < 4; ++e) {
        float res[2];
#pragma unroll
        for (int hh = 0; hh < 2; ++hh) {
          int ci = half * 8 + e * 2 + hh;
          float c = hh ? bfhi(cw[e]) : bflo(cw[e]);
          float pp = hh ? bfhi(pw[e]) : bflo(pw[e]);
          float nn = hh ? bfhi(nw4[e]) : bflo(nw4[e]);
          float g = hh ? bfhi(gw4[e]) : bflo(gw4[e]);
          float vsh = c + mu0[ci] * (pp - c) + mu1[ci] * (nn - c);
          float on = (o[ci] - mean) * rstd * p.ev_gn_w[li * DA + cbase + ci] + p.ev_gn_b[li * DA + cbase + ci];
          res[hh] = (on + rks * vsh) * siluf_(g);
        }
        outw[e] = pack2(res[0], res[1]);
      }
      *(uint4*)(yp + half * 8) = make_uint4(outw[0], outw[1], outw[2], outw[3]);
    }
  }
}

__device__ void odd_tiles(int tid_, int bid_, int nblk_, const Params& p, int oi, int mode, bool skip_ctx, char* smem) {
  const int tid = tid_, lane = tid & 63, w = __builtin_amdgcn_readfirstlane(tid >> 6);
  const int fr = lane & 15, fq = lane >> 4;
  u16* sU = (u16*)smem;
  float* sA = (float*)(smem + 32 * 168 * 2);
  float* sB = sA + 32 * 160;
  float* sHf = sB + 32 * 160;
  const int ntiles = NB * NCH * 16;
  const int mt = w & 1, nh = w >> 1;
  uint2 xr[5][4];
#define ODD_DECODE(TILE)                                                              \
  const int blk = (TILE) & 15, cgl = ((TILE) >> 4) % NCH, b = ((TILE) >> 4) / NCH;    \
  int rowbase, T, t0;                                                                 \
  if (cgl < 8) { rowbase = MLAT + b * CTX; T = CTX; t0 = cgl * 32; }                  \
  else { rowbase = b * SEQ; T = SEQ; t0 = (cgl - 8) * 32; }                           \
  const int cb = blk * 160;
#define ODD_PREFETCH(TILE)                                                            \
  {                                                                                   \
    ODD_DECODE(TILE)                                                                  \
    _Pragma("unroll") for (int i = 0; i < 5; ++i) {                                   \
      int e = tid + i * 256, t = e / 40, c4 = (e % 40) * 4;                           \
      _Pragma("unroll") for (int j = 0; j < 4; ++j) {                                 \
        int tt = t0 + t - 2 + j;                                                      \
        xr[i][j] = (tt >= 0 && tt < T)                                                \
                       ? *(const uint2*)(p.P + (size_t)(rowbase + tt) * OD_IN + cb + c4) \
                       : make_uint2(0u, 0u);                                          \
      }                                                                               \
    }                                                                                 \
  }
  int tile = bid_;
  while (tile < ntiles && skip_ctx && ((tile >> 4) % NCH) < 8) tile += nblk_;
  if (tile < ntiles) ODD_PREFETCH(tile)
  while (tile < ntiles) {
    ODD_DECODE(tile)
#pragma unroll
    for (int i = 0; i < 5; ++i) {
      int e = tid + i * 256, t = e / 40, c4 = (e % 40) * 4;
      float4 acc = *(const float4*)(p.od_conv_b + oi * DC + cb + c4);
#pragma unroll
      for (int j = 0; j < 4; ++j) {
        uint2 xv = xr[i][j];
        float4 wv = *(const float4*)(p.od_conv_w + ((size_t)oi * 4 + j) * DC + cb + c4);
        acc.x += bflo(xv.x) * wv.x; acc.y += bfhi(xv.x) * wv.y; acc.z += bflo(xv.y) * wv.z; acc.w += bfhi(xv.y) * wv.w;
      }
      uint2 o;
      o.x = pack2(acc.x, acc.y);
      o.y = pack2(acc.z, acc.w);
      *(uint2*)(sU + t * 168 + c4) = o;
    }
    lds_barrier();
    int nxt = tile + nblk_;
    while (nxt < ntiles && skip_ctx && ((nxt >> 4) % NCH) < 8) nxt += nblk_;
    if (nxt < ntiles) ODD_PREFETCH(nxt)
    float cin0 = 0.f, cin1 = 0.f;
    uint2 gv[5];
    unsigned* abrow;
    {
      const int r0 = rowbase + t0;
      abrow = ((r0 < AB_R1) ? (p.abA + (size_t)r0 * DC) : (p.abB + (size_t)(r0 - AB_R1) * DC)) + cb;
    }
    if (mode == 1) {
      if (tid < 160) {
        const size_t sidx0 = ((size_t)((b * NCH + cgl) * 2 + 0)) * DC + cb + tid;
        cin0 = p.carry[sidx0];
        cin1 = p.carry[sidx0 + DC];
      }
#pragma unroll
      for (int i = 0; i < 5; ++i) {
        int e = tid + i * 256, t = e / 40, c4 = (e % 40) * 4;
        gv[i] = *(const uint2*)(p.P + (size_t)(rowbase + t0 + t) * OD_IN + DC + cb + c4);
      }
    }
    bf16x8 au[5];
#pragma unroll
    for (int ks = 0; ks < 5; ++ks) au[ks] = *(const bf16x8*)(sU + (mt * 16 + fr) * 168 + ks * 32 + fq * 8);
    for (int d = 0; d < 2; ++d) {
      const u16* Wg = p.wt_gate + ((size_t)((oi * 2 + d) * 16 + blk)) * 320 * 160;
      const float* gab = p.od_ga_b + (size_t)(oi * 2 + d) * DC + cb;
      const float* gxb = p.od_gx_b + (size_t)(oi * 2 + d) * DC + cb;
      const float* lam = p.od_lambda + (size_t)(oi * 2 + d) * DC + cb;
      float bavv[5], bxvv[5], splv[5];
#pragma unroll
      for (int q = 0; q < 5; ++q) {
        const int c = (nh * 5 + q) * 16 + fr;
        bavv[q] = gab[c];
        bxvv[q] = gxb[c];
        splv[q] = lam[c];
      }
      if (mode == 1 && d == 0) {
#pragma unroll
        for (int i = 0; i < 5; ++i) {
          int e = tid + i * 256, t = e / 40, c4 = (e % 40) * 4;
          const uint4 abq = *(const uint4*)(abrow + (size_t)t * DC + c4);
          unsigned wv[4] = {abq.x, abq.y, abq.z, abq.w};
          float av[4], bv4[4];
#pragma unroll
          for (int q = 0; q < 4; ++q) { av[q] = __expf(h2f_bits(wv[q])); bv4[q] = h2f_bits(wv[q] >> 16); }
          *(float4*)(sA + t * 160 + c4) = make_float4(av[0], av[1], av[2], av[3]);
          *(float4*)(sB + t * 160 + c4) = make_float4(bv4[0], bv4[1], bv4[2], bv4[3]);
        }
      } else {
      bf16x8 bA[5], bX[5];
      {
        const u16* wa = Wg + (size_t)(nh * 5 * 16 + fr) * 160 + fq * 8;
#pragma unroll
        for (int ks = 0; ks < 5; ++ks) {
          bA[ks] = *(const bf16x8*)(wa + ks * 32);
          bX[ks] = *(const bf16x8*)(wa + (size_t)160 * 160 + ks * 32);
        }
      }
#pragma unroll
      for (int nti = 0; nti < 5; ++nti) {
        const int nt = nh * 5 + nti;
        f32x4 accA = {0.f, 0.f, 0.f, 0.f}, accX = {0.f, 0.f, 0.f, 0.f};
#pragma unroll
        for (int ks = 0; ks < 5; ++ks) {
          accA = __builtin_amdgcn_mfma_f32_16x16x32_bf16(au[ks], bA[ks], accA, 0, 0, 0);
          accX = __builtin_amdgcn_mfma_f32_16x16x32_bf16(au[ks], bX[ks], accX, 0, 0, 0);
        }
        if (nti + 1 < 5) {
          const u16* wa = Wg + (size_t)((nt + 1) * 16 + fr) * 160 + fq * 8;
#pragma unroll
          for (int ks = 0; ks < 5; ++ks) {
            bA[ks] = *(const bf16x8*)(wa + ks * 32);
            bX[ks] = *(const bf16x8*)(wa + (size_t)160 * 160 + ks * 32);
          }
        }
        const int c = nt * 16 + fr;
        const float bav = bavv[nti], bxv = bxvv[nti];
        const float spl = softplusf_(-splv[nti]);
#pragma unroll
        for (int j = 0; j < 4; ++j) {
          int t = mt * 16 + fq * 4 + j;
          float gr = sigmoidf_(accA[j] + bav);
          float gi = sigmoidf_(accX[j] + bxv);
          float la = -8.f * gr * spl;
          float a = __expf(la);
          float uu = bf2f(sU[t * 168 + c]);
          float bb = __builtin_amdgcn_sqrtf(fmaxf(1.f - a * a, 0.f)) * gi * uu;
          if (d == 0) {
            const unsigned hl = f2h_bits(la), hb = f2h_bits(bb);
            a = __expf(h2f_bits(hl));
            bb = h2f_bits(hb);
            if (mode == 0) abrow[(size_t)t * DC + c] = hl | (hb << 16);
          }
          sA[t * 160 + c] = a;
          sB[t * 160 + c] = bb;
        }
      }
      }
      lds_barrier();
      if (tid < 160) {
        const int c = tid;
        const size_t sidx = ((size_t)((b * NCH + cgl) * 2 + d)) * DC + cb + c;
        if (mode == 0) {
          float hacc = 0.f, ap = 1.f;
#pragma unroll 4
          for (int s = 0; s < 32; ++s) {
            int t = d ? 31 - s : s;
            float a = sA[t * 160 + c];
            hacc = a * hacc + sB[t * 160 + c];
            ap *= a;
          }
          p.summ[sidx * 2] = ap;
          p.summ[sidx * 2 + 1] = hacc;
        } else {
          float hacc = d ? cin1 : cin0;
          float* dst = d ? sB : sHf;
#pragma unroll 4
          for (int s = 0; s < 32; ++s) {
            int t = d ? 31 - s : s;
            hacc = sA[t * 160 + c] * hacc + sB[t * 160 + c];
            dst[t * 160 + c] = hacc;
          }
        }
      }
      lds_barrier();
    }
    if (mode == 1) {
#pragma unroll
      for (int i = 0; i < 5; ++i) {
        int e = tid + i * 256, t = e / 40, c4 = (e % 40) * 4;
        size_t row = (size_t)(rowbase + t0 + t);
        float4 hf = *(const float4*)(sHf + t * 160 + c4);
        float4 hb = *(const float4*)(sB + t * 160 + c4);
        float y0 = (hf.x + hb.x) * siluf_(bflo(gv[i].x));
        float y1 = (hf.y + hb.y) * siluf_(bfhi(gv[i].x));
        float y2 = (hf.z + hb.z) * siluf_(bflo(gv[i].y));
        float y3 = (hf.w + hb.w) * siluf_(bfhi(gv[i].y));
        uint2 o;
        o.x = pack2(y0, y1);
        o.y = pack2(y2, y3);
        *(uint2*)(p.y + row * DC + cb + c4) = o;
      }
      lds_barrier();
    }
    tile = nxt;
  }
#undef ODD_DECODE
#undef ODD_PREFETCH
}

__device__ void odd_carry(int tid_, int bid_, int nblk_, const Params& p, char* smem) {
  float2* sSeg = (float2*)smem;
  const int seg = tid_ >> 5, cl = tid_ & 31;
  const float2* __restrict__ summ2 = (const float2*)p.summ;
  float* __restrict__ carry = p.carry;
  const int ncg = DC / 32;
  for (int item = bid_; item < NB * 2 * ncg; item += nblk_) {
    const int cg = item % ncg, d = (item / ncg) & 1, b = item / (2 * ncg);
    const int C = cg * 32 + cl;
    size_t sidx[17];
    float2 sv[17];
#pragma unroll
    for (int q = 0; q < 17; ++q) {
      const int i = seg * 17 + q;
      const int cgl = (d == 0) ? i : ((i < 8) ? (7 - i) : (NCH - 1 - (i - 8)));
      sidx[q] = ((size_t)((b * NCH + cgl) * 2 + d)) * DC + C;
      sv[q] = summ2[sidx[q]];
    }
    float A = 1.f, H = 0.f;
#pragma unroll
    for (int q = 0; q < 17; ++q) { H = sv[q].x * H + sv[q].y; A *= sv[q].x; }
    __syncthreads();
    sSeg[seg * 32 + cl] = make_float2(A, H);
    __syncthreads();
    float hcur = 0.f;
    for (int s2 = 0; s2 < seg; ++s2) {
      const float2 g = sSeg[s2 * 32 + cl];
      hcur = g.x * hcur + g.y;
    }
#pragma unroll
    for (int q = 0; q < 17; ++q) {
      carry[sidx[q]] = hcur;
      hcur = sv[q].x * hcur + sv[q].y;
    }
  }
}

__device__ void run_phase(int tid_, int bid_, int nblk_, const Params& p, int ph, char* smem) {
#ifndef HALF_MASK
#define HALF_MASK 0
#endif
  {
    int type;
    if (ph == 0) type = 0;
    else if (ph == 1 || ph == 6 || ph == 12 || ph == 17 || ph == 23) type = 1;
    else if (ph == 2 || ph == 5 || ph == 7 || ph == 11 || ph == 13 || ph == 16 || ph == 18 || ph == 22) type = 2;
    else if (ph == 3 || ph == 14) type = 3;
    else if (ph == 4 || ph == 15) type = 4;
    else if (ph == 9 || ph == 20) type = 6;
    else type = 5;
    if ((HALF_MASK >> type) & 1) {
      if (bid_ >= 256) return;
      nblk_ = 256;
    }
  }
  if (ph == 0) {
    float* sm = (float*)smem;
    if (bid_ == 0 && tid_ < 64) p.cnt[tid_] = 0;
    transpose_job64(tid_, bid_, nblk_, p.ev_w_in, p.wt_ev_in, 2048, EV_IN, 1, (size_t)2048 * EV_IN, (size_t)2048 * EV_IN, 2048, sm);
    mod_phase(tid_, bid_, nblk_, p, smem, 0, 96);
    return;
  }
  if (ph == 1) { norm_phase(tid_, bid_, nblk_, p, -1, 0); return; }
  int L, s;
  if (ph <= 6) { L = 0; s = ph - 2; }
  else if (ph <= 12) { L = 1; s = ph - 7; }
  else if (ph <= 17) { L = 2; s = ph - 13; }
  else { L = 3; s = ph - 18; }
  const int i2 = L >> 1;
  if ((L & 1) == 0) {
    switch (s) {
      case 0:
        gemm_phase<1>(tid_, bid_, nblk_, p.h, D, p.wt_ev_in + (size_t)i2 * EV_IN * 2048, 2048, EV_IN, p.P, EV_IN, p.vtL, p.vtC, smem);
        break;
      case 1: mix_phase(tid_, bid_, nblk_, p, i2, smem); break;
      case 2: readout_phase(tid_, bid_, nblk_, p, i2); break;
      case 3:
        gemm_phase<2>(tid_, bid_, nblk_, p.y, 2048, p.wt_ev_out + (size_t)i2 * 2048 * 2048, 2048, 2048, p.z, 2048, nullptr, nullptr, smem);
        break;
      default: norm_phase(tid_, bid_, nblk_, p, L, L + 1); break;
    }
  } else {
    switch (s) {
      case 0:
        gemm_phase<0>(tid_, bid_, nblk_, p.h, D, p.wt_od_in + (size_t)i2 * OD_IN * 2048, 2048, OD_IN, p.P, OD_IN, nullptr, nullptr, smem);
        break;
      case 1: odd_tiles(tid_, bid_, nblk_, p, i2, 0, false, smem); break;
      case 2: odd_carry(tid_, bid_, nblk_, p, smem); break;
      case 3: odd_tiles(tid_, bid_, nblk_, p, i2, 1, L == 3, smem); break;
      case 4:
        gemm_phase<2>(tid_, bid_, nblk_, p.y, DC, p.wt_od_out + (size_t)i2 * 2048 * DC, DC, 2048, p.z, 2048, nullptr, nullptr, smem,
                      (L == 3) ? MLAT / 128 : MTOT / 128);
        break;
      default: norm_phase(tid_, bid_, nblk_, p, L, L + 1); break;
    }
  }
}


#define XB_TMO      128
#define XB_XCNT(j)  (256  + 64 * (j))
#define XB_XSUB(j)  (1280 + 64 * (j))
#define XB_XGEN(j)  (2304 + 64 * (j))
#define XB_TOP      3328
#define XB_TOPGEN   3392
#define XCD_BAR_WORDS 3456
#define XB_SPIN_CAP (1u << 18)
#define LAS __attribute__((address_space(3)))

__device__ __forceinline__ unsigned xb_ld(unsigned* p) { return __hip_atomic_load(p, __ATOMIC_RELAXED, __HIP_MEMORY_SCOPE_AGENT); }
__device__ __forceinline__ unsigned xb_add(unsigned* p, unsigned v) { return __hip_atomic_fetch_add(p, v, __ATOMIC_RELAXED, __HIP_MEMORY_SCOPE_AGENT); }
__device__ __forceinline__ unsigned xb_xcc_id() { return (unsigned)__builtin_amdgcn_s_getreg((3 << 11) | 20) & 0xFu; }
#define XB_SPIN(cond, bar) do { unsigned _sp = 0; while (cond) { __builtin_amdgcn_s_sleep(1); \
    if ((++_sp & 255u) == 0u) { if (xb_ld(&(bar)[XB_TMO])) break; if (_sp > XB_SPIN_CAP) { atomicAdd(&(bar)[XB_TMO], 1u); break; } } } } while (0)

struct XcdBarrier {
  unsigned* bar; unsigned x;
  volatile LAS unsigned* st;
};

__device__ __forceinline__ XcdBarrier xcd_barrier_post(unsigned* bar, volatile LAS unsigned* st) {
  XcdBarrier b; b.bar = bar; b.x = xb_xcc_id(); b.st = st;
  if (threadIdx.x == 0) (void)xb_add(&bar[XB_XCNT(b.x)], 1u);
  return b;
}
__device__ __forceinline__ void xcd_barrier_complete(unsigned* bar, unsigned x, unsigned& nloc, unsigned& nx) {
  const unsigned G = gridDim.x * gridDim.y * gridDim.z;
  unsigned sum, cnt, mine, sp = 0u;
  for (;;) {
    sum = 0u; cnt = 0u; mine = 0u;
#pragma unroll
    for (unsigned j = 0; j < 16; ++j) { const unsigned c = xb_ld(&bar[XB_XCNT(j)]); sum += c; cnt += (c > 0u) ? 1u : 0u; mine = (j == x) ? c : mine; }
    if (sum == G) break;
    __builtin_amdgcn_s_sleep(1);
    if ((++sp & 255u) == 0u) { if (xb_ld(&bar[XB_TMO])) break; if (sp > XB_SPIN_CAP) { atomicAdd(&bar[XB_TMO], 1u); break; } }
  }
  nloc = mine > 0u ? mine : 1u; nx = cnt > 0u ? cnt : 1u;
}
__device__ __forceinline__ void xcd_barrier(const XcdBarrier& b) {
  asm volatile("s_waitcnt vmcnt(0)" ::: "memory");
  __syncthreads();
  if (threadIdx.x == 0) {
    unsigned* bar = b.bar;
    __builtin_amdgcn_s_waitcnt(0);
    unsigned nloc = b.st[0], nx = b.st[1];
    if (nloc == 0u) { xcd_barrier_complete(bar, b.x, nloc, nx); b.st[0] = nloc; b.st[1] = nx; }
    const unsigned old = xb_add(&bar[XB_XSUB(b.x)], 1u);
    const unsigned gen = old / nloc;
    if (old + 1u == (gen + 1u) * nloc) {
      __builtin_amdgcn_fence(__ATOMIC_RELEASE, "agent");
      asm volatile("s_waitcnt vmcnt(0)" ::: "memory");
      const unsigned og = xb_add(&bar[XB_TOP], 1u);
      const unsigned tg = og / nx;
      if (og + 1u == (tg + 1u) * nx) xb_add(&bar[XB_TOPGEN], 1u);
      else XB_SPIN(xb_ld(&bar[XB_TOPGEN]) == tg, bar);
      __builtin_amdgcn_fence(__ATOMIC_ACQUIRE, "agent");
      xb_add(&bar[XB_XGEN(b.x)], 1u);
      asm volatile("s_waitcnt vmcnt(0)" ::: "memory");
    } else {
      XB_SPIN(xb_ld(&bar[XB_XGEN(b.x)]) == gen, bar);
      __builtin_amdgcn_fence(__ATOMIC_ACQUIRE, "agent");
      asm volatile("s_waitcnt vmcnt(0)" ::: "memory");
    }
  }
  __syncthreads();
}

__global__ void __launch_bounds__(256, 2) fwd_megakernel(Params p) {
  __shared__ __attribute__((aligned(16))) char smem[SMEM_BYTES];
  cg::grid_group grid = cg::this_grid();
  volatile LAS unsigned* xst = (volatile LAS unsigned*)(smem + SMEM_BYTES - 32);
  if (threadIdx.x == 0) { xst[0] = 0u; xst[1] = 0u; }
  __syncthreads();
  const XcdBarrier xb = xcd_barrier_post(p.bar, xst);
  for (int ph = p.ph0; ph < p.ph1; ++ph) {
    int tid_ = threadIdx.x, bid_ = blockIdx.x, nblk_ = gridDim.x;
    asm volatile("" : "+v"(tid_), "+s"(bid_));
    run_phase(tid_, bid_, nblk_, p, ph, smem);
    if (ph + 1 < p.ph1) {
      if (p.ph0 < 0) grid.sync();
      xcd_barrier(xb);
    }
  }
}

extern "C" void kernel_launch(void* const* d_in, const int* in_sizes, int n_in, void* d_out, int out_size, void* d_ws,
                              size_t ws_size, hipStream_t stream) {
  static int grid_blocks = 0;
  if (!grid_blocks) {
    int dev = 0, cus = 0, per_cu = 0;
    hipGetDevice(&dev);
    hipDeviceGetAttribute(&cus, hipDeviceAttributeMultiprocessorCount, dev);
    hipOccupancyMaxActiveBlocksPerMultiprocessor(&per_cu, fwd_megakernel, 256, 0);
    if (per_cu > 2) per_cu = 2;
    if (per_cu < 1) per_cu = 1;
    grid_blocks = cus * per_cu;
  }
  Params p{};
  const float* const* in = (const float* const*)d_in;
  p.x = in[0]; p.c = in[1]; p.ctx = in[2]; p.c_ctx = in[3]; p.mod_w = in[4]; p.mod_b = in[5];
  p.norm_pre = in[6]; p.norm_post = in[7];
  p.ev_w_in = in[8]; p.ev_mu = in[9]; p.ev_w0 = in[10]; p.ev_w_up = in[11]; p.ev_a0 = in[12]; p.ev_a_up = in[13];
  p.ev_k_k = in[14]; p.ev_k_a = in[15]; p.ev_r_k = in[16]; p.ev_gn_w = in[17]; p.ev_gn_b = in[18]; p.ev_rpb = in[19];
  p.ev_w_out = in[20];
  p.od_w_in = in[21]; p.od_conv_w = in[22]; p.od_conv_b = in[23]; p.od_ga_w = in[24]; p.od_ga_b = in[25];
  p.od_gx_w = in[26]; p.od_gx_b = in[27]; p.od_lambda = in[28]; p.od_w_out = in[29];
  p.out = (float*)d_out;
  char* ws = (char*)d_ws;
  size_t off = 0;
  auto take = [&](size_t bytes) { char* r = ws + off; off += (bytes + 255) & ~(size_t)255; return r; };
  p.wt_ev_in = (u16*)take((size_t)2 * EV_IN * 2048 * 2);
  p.wt_ev_out = (u16*)take((size_t)2 * 2048 * 2048 * 2);
  p.wt_od_in = (u16*)take((size_t)2 * OD_IN * 2048 * 2);
  p.wt_od_out = (u16*)take((size_t)2 * 2048 * DC * 2);
  p.wt_gate = (u16*)take((size_t)64 * 320 * 160 * 2);
  p.mod = (float*)take((size_t)4 * 5 * 6144 * 4);
  p.xc = (float*)take((size_t)MCTX * D * 4);
  p.P = (u16*)take((size_t)MTOT * EV_IN * 2);
  p.z = (float*)p.P;
  p.y = (u16*)take((size_t)MTOT * DC * 2);
  p.vtL = (u16*)take((size_t)NB * 1024 * SEQ * 2);
  p.vtC = (u16*)take((size_t)NB * 1024 * CTX * 2);
  p.rk = (float*)take((size_t)2 * MTOT * 16 * 4);
  p.cnt = (int*)take(256);
  p.bar = (unsigned*)take((size_t)XCD_BAR_WORDS * 4);
  char* region = take((size_t)2 * MTOT * DA * 4);
  p.h = (u16*)region;
  p.o_scan = (float*)region;
  p.abA = (unsigned*)((char*)p.P + (size_t)MTOT * OD_IN * 2);
  p.abB = (unsigned*)region;
  p.summ = (float*)(region + (size_t)MTOT * D * 2);
  p.carry = p.summ + (size_t)NB * NCH * 2 * DC * 2;
  p.ph0 = 0;
  p.ph1 = 24;
  if (off > ws_size) {
    fprintf(stderr, "workspace too small: need %zu have %zu\n", off, ws_size);
    return;
  }
  (void)hipMemsetAsync(p.bar, 0, (size_t)XCD_BAR_WORDS * 4, stream);
  void* args[] = {&p};
  hipError_t e = hipLaunchCooperativeKernel((void*)fwd_megakernel, dim3(grid_blocks), dim3(256), args, 0, stream);
  if (e != hipSuccess) fprintf(stderr, "cooperative launch failed: %s (grid %d)\n", hipGetErrorString(e), grid_blocks);
}
```
